# Optimizing an MI355X kernel written in HIP

```python
import math
import jax, jax.numpy as jnp
from jax import lax
import numpy as np

D_MODEL = 2048
BATCH = 2
SEQ = 8192
DEPTH = 1

MIX_WIDTH = D_MODEL
GDN_WIDTH = MIX_WIDTH // 2
GDN_HEAD_DIM = 128
GDN_HEADS = GDN_WIDTH // GDN_HEAD_DIM
GDN_CHUNK = 64
CONV_WIDTH = 4
RG_WIDTH = MIX_WIDTH - GDN_WIDTH
RG_BLOCKS = 8
RG_BLOCK_DIM = RG_WIDTH // RG_BLOCKS
LRU_C = 8.0
N_GROUPS = 4
EXPERTS_PER_GROUP = 8
N_EXPERTS = N_GROUPS * EXPERTS_PER_GROUP
TOP_K = 2
EXPERT_FF = D_MODEL // 4
NORM_EPS = 1e-6
IN_COLS = 4 * GDN_WIDTH + 2 * GDN_HEADS + 2 * RG_WIDTH

kernel_name = "hymba_gdn_rglru_hmoe_block"


def rms_norm(x, w):
    xf = x.astype(jnp.float32)
    y = xf * lax.rsqrt(jnp.mean(xf * xf, axis=-1, keepdims=True) + NORM_EPS)
    return (y * w.astype(jnp.float32)).astype(x.dtype)


def l2_normalize(x):
    return x * lax.rsqrt(jnp.sum(x * x, axis=-1, keepdims=True) + NORM_EPS)


def causal_depthwise_conv(x, w):
    c = x.shape[-1]
    return lax.conv_general_dilated(
        x, w[:, None, :].astype(x.dtype), window_strides=(1,),
        padding=[(w.shape[0] - 1, 0)], dimension_numbers=("NWC", "WIO", "NWC"),
        feature_group_count=c)


def chunk_gated_delta_rule(q, k, v, g, beta):
    b_, t_, h_, dk = q.shape
    dv = v.shape[-1]
    c_ = GDN_CHUNK
    n_ = t_ // c_

    def to_chunks(t):
        return t.reshape(b_, n_, c_, h_, -1).transpose(0, 3, 1, 2, 4)

    q, k, v = to_chunks(q), to_chunks(k), to_chunks(v)
    g = g.reshape(b_, n_, c_, h_).transpose(0, 3, 1, 2)
    beta = beta.reshape(b_, n_, c_, h_).transpose(0, 3, 1, 2)
    g_cum = jnp.cumsum(g, axis=-1)

    causal = jnp.tril(jnp.ones((c_, c_), dtype=bool))
    strict = jnp.tril(jnp.ones((c_, c_), dtype=bool), -1)
    diff = g_cum[..., :, None] - g_cum[..., None, :]
    decay = jnp.exp(jnp.where(causal, diff, -jnp.inf))

    kk = jnp.einsum("bhnik,bhnjk->bhnij", k, k)
    a_strict = jnp.where(strict, beta[..., :, None] * kk * decay, 0.0)
    lhs = a_strict + jnp.eye(c_, dtype=jnp.float32)
    rhs = jnp.concatenate(
        [v * beta[..., None], k * (beta * jnp.exp(g_cum))[..., None]], axis=-1)
    sol = lax.linalg.triangular_solve(lhs, rhs, left_side=True, lower=True,
                                      unit_diagonal=True)
    u = sol[..., :dv]
    w = sol[..., dv:]

    attn_intra = jnp.einsum("bhnik,bhnjk->bhnij", q, k) * decay

    def move(t):
        return jnp.moveaxis(t, 2, 0)

    def step(state, inp):
        q_c, k_c, u_c, w_c, g_c, at_c = inp
        v_new = u_c - jnp.einsum("bhck,bhkv->bhcv", w_c, state)
        o_c = (jnp.einsum("bhck,bhkv->bhcv", q_c * jnp.exp(g_c)[..., None], state)
               + jnp.einsum("bhij,bhjv->bhiv", at_c, v_new))
        g_last = g_c[..., -1]
        k_dec = k_c * jnp.exp(g_last[..., None] - g_c)[..., None]
        state = (state * jnp.exp(g_last)[..., None, None]
                 + jnp.einsum("bhck,bhcv->bhkv", k_dec, v_new))
        return state, o_c

    s0 = jnp.zeros((b_, h_, dk, dv), jnp.float32)
    _, o = lax.scan(step, s0, (move(q), move(k), move(u), move(w), move(g_cum),
                               move(attn_intra)))
    return o.transpose(1, 0, 3, 2, 4).reshape(b_, t_, h_, dv)


def gated_deltanet_group(q, k, v, z, b, a, conv_w, a_log, dt_bias, norm_w):
    b_, t_, _ = q.shape
    qkv = jax.nn.silu(causal_depthwise_conv(jnp.concatenate([q, k, v], axis=-1), conv_w))
    qkv = qkv.astype(jnp.float32)
    q, k, v = jnp.split(qkv, 3, axis=-1)
    shp = (b_, t_, GDN_HEADS, GDN_HEAD_DIM)
    q = l2_normalize(q.reshape(shp)) * (GDN_HEAD_DIM ** -0.5)
    k = l2_normalize(k.reshape(shp))
    v = v.reshape(shp)
    beta = jax.nn.sigmoid(b.astype(jnp.float32))
    g = -jnp.exp(a_log.astype(jnp.float32)) * jax.nn.softplus(
        a.astype(jnp.float32) + dt_bias.astype(jnp.float32))
    o = chunk_gated_delta_rule(q, k, v, g, beta)
    o = rms_norm(o, norm_w) * jax.nn.silu(z.astype(jnp.float32).reshape(shp))
    return o.reshape(b_, t_, GDN_WIDTH)


def lru_combine(c1, c2):
    a1, b1 = c1
    a2, b2 = c2
    return a1 * a2, a2 * b1 + b2


def rglru_group(xr, gate, conv_w, conv_b, w_rgate, b_rgate, w_igate, b_igate, lam, norm_w):
    b_, t_, _ = xr.shape
    xc = (causal_depthwise_conv(xr, conv_w) + conv_b).astype(jnp.float32)
    xb = xc.reshape(b_, t_, RG_BLOCKS, RG_BLOCK_DIM)
    r = jax.nn.sigmoid(jnp.einsum("btni,nij->btnj", xb, w_rgate.astype(jnp.float32))
                       + b_rgate.astype(jnp.float32).reshape(RG_BLOCKS, RG_BLOCK_DIM))
    i = jax.nn.sigmoid(jnp.einsum("btni,nij->btnj", xb, w_igate.astype(jnp.float32))
                       + b_igate.astype(jnp.float32).reshape(RG_BLOCKS, RG_BLOCK_DIM))
    r = r.reshape(b_, t_, RG_WIDTH)
    i = i.reshape(b_, t_, RG_WIDTH)
    log_a = -LRU_C * r * jax.nn.softplus(-lam.astype(jnp.float32))
    a_t = jnp.exp(log_a)
    mult = jnp.sqrt(-jnp.expm1(2.0 * log_a))
    _, h = lax.associative_scan(lru_combine, (a_t, mult * (i * xc)), axis=1)
    y = h * jax.nn.gelu(gate.astype(jnp.float32))
    y = rms_norm(y.reshape(b_, t_, RG_BLOCKS, RG_BLOCK_DIM),
                 norm_w.reshape(RG_BLOCKS, RG_BLOCK_DIM))
    return y.reshape(b_, t_, RG_WIDTH)


def hierarchical_moe(h, w_group, b_group, w_expert, b_expert, w1, w3, w2):
    b_, t_, d_ = h.shape
    xt = h.reshape(-1, d_)
    grp_prob = jax.nn.softmax((xt @ w_group).astype(jnp.float32)
                              + b_group.astype(jnp.float32), axis=-1)
    grp_p, grp_idx = lax.top_k(grp_prob, 1)
    exp_logits = ((xt @ w_expert).astype(jnp.float32) + b_expert.astype(jnp.float32)
                  ).reshape(-1, N_GROUPS, EXPERTS_PER_GROUP)
    sel_logits = jnp.take_along_axis(exp_logits, grp_idx[:, :, None], axis=1)[:, 0]
    top_p, top_idx = lax.top_k(jax.nn.softmax(sel_logits, axis=-1), TOP_K)
    top_p = top_p / jnp.sum(top_p, axis=-1, keepdims=True)
    gate = grp_p * top_p
    global_idx = grp_idx * EXPERTS_PER_GROUP + top_idx
    combine = jnp.sum(jax.nn.one_hot(global_idx, N_EXPERTS, dtype=jnp.float32)
                      * gate[..., None], axis=1)
    y = jnp.zeros(xt.shape, jnp.float32)
    for e in range(N_EXPERTS):
        he = jax.nn.silu(xt @ w1[e]) * (xt @ w3[e])
        y = y + combine[:, e:e + 1] * (he @ w2[e]).astype(jnp.float32)
    return y.astype(h.dtype).reshape(b_, t_, d_)


def setup_inputs(seed: int = 0) -> dict:
    key = jax.random.key(seed)
    ks = jax.random.split(key, 25)
    L = DEPTH
    f32 = jnp.float32

    def nrm(k, shape, scale):
        return jax.random.normal(k, shape, f32) * scale

    def gain(k, shape):
        return 1.0 + 0.02 * jax.random.normal(k, shape, f32)

    dt = jnp.exp(jax.random.uniform(ks[5], (L, GDN_HEADS), f32,
                                    minval=math.log(1e-3), maxval=math.log(1e-1)))
    a_init = jax.random.uniform(ks[13], (L, RG_WIDTH), f32, minval=0.9, maxval=0.999)
    a_base = a_init ** (1.0 / LRU_C)
    return {
        "x": nrm(ks[0], (BATCH, SEQ, D_MODEL), 1.0),
        "norm_mix_w": gain(ks[1], (L, D_MODEL)),
        "w_in": nrm(ks[2], (L, D_MODEL, IN_COLS), D_MODEL ** -0.5),
        "gdn_conv_w": nrm(ks[3], (L, CONV_WIDTH, 3 * GDN_WIDTH), CONV_WIDTH ** -0.5),
        "gdn_a_log": jnp.log(jax.random.uniform(ks[4], (L, GDN_HEADS), f32,
                                                minval=1.0, maxval=16.0)),
        "gdn_dt_bias": dt + jnp.log(-jnp.expm1(-dt)),
        "gdn_norm_w": gain(ks[6], (L, GDN_HEAD_DIM)),
        "rg_conv_w": nrm(ks[7], (L, CONV_WIDTH, RG_WIDTH), CONV_WIDTH ** -0.5),
        "rg_conv_b": nrm(ks[8], (L, RG_WIDTH), 0.01),
        "rg_w_rgate": nrm(ks[9], (L, RG_BLOCKS, RG_BLOCK_DIM, RG_BLOCK_DIM), RG_BLOCK_DIM ** -0.5),
        "rg_b_rgate": nrm(ks[10], (L, RG_WIDTH), 0.01),
        "rg_w_igate": nrm(ks[11], (L, RG_BLOCKS, RG_BLOCK_DIM, RG_BLOCK_DIM), RG_BLOCK_DIM ** -0.5),
        "rg_b_igate": nrm(ks[12], (L, RG_WIDTH), 0.01),
        "rg_lambda": jnp.log(a_base) - jnp.log1p(-a_base),
        "rg_norm_w": gain(ks[14], (L, RG_WIDTH)),
        "w_out": nrm(ks[15], (L, MIX_WIDTH, D_MODEL), MIX_WIDTH ** -0.5),
        "norm_ffn_w": gain(ks[16], (L, D_MODEL)),
        "router_w_group": nrm(ks[17], (L, D_MODEL, N_GROUPS), D_MODEL ** -0.5),
        "router_b_group": nrm(ks[18], (L, N_GROUPS), 0.01),
        "router_w_expert": nrm(ks[19], (L, D_MODEL, N_EXPERTS), D_MODEL ** -0.5),
        "router_b_expert": nrm(ks[20], (L, N_EXPERTS), 0.01),
        "expert_w1": nrm(ks[21], (L, N_EXPERTS, D_MODEL, EXPERT_FF), D_MODEL ** -0.5),
        "expert_w3": nrm(ks[22], (L, N_EXPERTS, D_MODEL, EXPERT_FF), D_MODEL ** -0.5),
        "expert_w2": nrm(ks[23], (L, N_EXPERTS, EXPERT_FF, D_MODEL), EXPERT_FF ** -0.5),
        "norm_final_w": gain(ks[24], (D_MODEL,)),
    }


def reference(x, norm_mix_w, w_in, gdn_conv_w, gdn_a_log, gdn_dt_bias, gdn_norm_w,
              rg_conv_w, rg_conv_b, rg_w_rgate, rg_b_rgate, rg_w_igate, rg_b_igate,
              rg_lambda, rg_norm_w, w_out, norm_ffn_w, router_w_group, router_b_group,
              router_w_expert, router_b_expert, expert_w1, expert_w3, expert_w2,
              norm_final_w):
    widths = [GDN_WIDTH, GDN_WIDTH, GDN_WIDTH, GDN_WIDTH, GDN_HEADS, GDN_HEADS,
              RG_WIDTH, RG_WIDTH]
    split_points = [int(s) for s in np.cumsum(widths)[:-1]]
    for l in range(DEPTH):
        h = rms_norm(x, norm_mix_w[l])
        proj = h @ w_in[l]
        q, k, v, z, b, a, rx, rgate = jnp.split(proj, split_points, axis=-1)
        y_gdn = gated_deltanet_group(q, k, v, z, b, a, gdn_conv_w[l], gdn_a_log[l],
                                     gdn_dt_bias[l], gdn_norm_w[l])
        y_rg = rglru_group(rx, rgate, rg_conv_w[l], rg_conv_b[l], rg_w_rgate[l],
                           rg_b_rgate[l], rg_w_igate[l], rg_b_igate[l], rg_lambda[l],
                           rg_norm_w[l])
        mix = jnp.concatenate([y_gdn, y_rg], axis=-1).astype(x.dtype)
        x = x + mix @ w_out[l]
        h = rms_norm(x, norm_ffn_w[l])
        x = x + hierarchical_moe(h, router_w_group[l], router_b_group[l],
                                 router_w_expert[l], router_b_expert[l],
                                 expert_w1[l], expert_w3[l], expert_w2[l])
    return rms_norm(x, norm_final_w)
```

```cpp
#include <hip/hip_runtime.h>
#include <cstdio>
#include <cstdint>

#define DI __device__ __forceinline__
#define LAS __attribute__((address_space(3)))
typedef unsigned short bf16_t;
typedef short bf16x8 __attribute__((ext_vector_type(8)));
typedef float f32x4 __attribute__((ext_vector_type(4)));
typedef float f32x2 __attribute__((ext_vector_type(2)));
typedef unsigned u32x4 __attribute__((ext_vector_type(4)));
typedef unsigned u32x2 __attribute__((ext_vector_type(2)));

constexpr int NB = 2, T = 8192, M = NB * T, D = 2048;
constexpr int NH = 8, HD = 128, GW = 1024, RW = 1024, RGB = 8, RBD = 128;
constexpr int NE = 32, NG = 4, EPG = 8, FF = 512;
constexpr int INCOLS = 6160, NPROJ = 6144;
constexpr float EPS = 1e-6f;
constexpr int NWAVES = 8, NTHREADS = 512;

constexpr size_t MiB = 1u << 20;
constexpr size_t WS_CTL = 0, CTL_BYTES = 1 * MiB;
constexpr size_t WS_BETA = 1 * MiB;
constexpr size_t WS_G = WS_BETA + 512 * 1024;
constexpr size_t WS_RSTD1 = 2 * MiB, WS_RSTD2 = 2 * MiB + 65536;
constexpr size_t WS_WG = 3 * MiB;
constexpr size_t WS_RGSUM = WS_WG + 512 * 1024;
constexpr size_t WS_LIST = 4 * MiB;
constexpr size_t WS_WOUT = 12 * MiB;
constexpr size_t WS_W13 = 20 * MiB;
constexpr size_t WS_W2 = 148 * MiB;
constexpr size_t WS_WIN = 212 * MiB;
constexpr size_t WS_XN = 236 * MiB;
constexpr size_t WS_PROJ = 300 * MiB;
constexpr size_t PROJ_STRIDE = 32 * MiB;
constexpr size_t WS_ORAW = 236 * MiB  ;
constexpr size_t WS_MIX = 492 * MiB;
constexpr size_t WS_X1 = WS_PROJ + 2 * PROJ_STRIDE;
constexpr size_t WS_H2 = WS_WIN;
constexpr size_t WS_HB = 276 * MiB;
constexpr size_t WS_Y2 = WS_W13;
constexpr size_t WS_END = 556 * MiB;
constexpr size_t WS_RGA = WS_WIN;
constexpr size_t WS_RGB = 276 * MiB;

constexpr int CW_CNT = 64;
constexpr int CW_BAR = 4096;

DI unsigned f2bf(float f) { unsigned u = __float_as_uint(f); return (u + 0x7fffu + ((u >> 16) & 1u)) >> 16; }
DI unsigned pk2(float lo, float hi) { return f2bf(lo) | (f2bf(hi) << 16); }
DI float bf2f(unsigned b) { return __uint_as_float(b << 16); }
DI float bflo(unsigned w) { return __uint_as_float(w << 16); }
DI float bfhi(unsigned w) { return __uint_as_float(w & 0xffff0000u); }
DI float wave_sum(float v) {
#pragma unroll
    for (int o = 1; o < 64; o <<= 1) v += __shfl_xor(v, o);
    return v;
}
DI float sigmoidf_(float x) { return 1.f / (1.f + __expf(-x)); }
DI float siluf_(float x) { return x / (1.f + __expf(-x)); }
DI float softplusf_(float x) { return x > 20.f ? x : log1pf(expf(x)); }
DI float gelu_tanh(float x) { const float u = 0.7978845608028654f * (x + 0.044715f * x * x * x); return 0.5f * x * (1.f + tanhf(u)); }

namespace pg8 {
constexpr int BM = 256, BK = 64, HALF = 128, HTB = HALF * BK * 2, STAGE_BYTES = 8 * HTB;
DI int lds_byte(int r, int c) { const int st = (r >> 4) * 2 + (c >> 5), rr = r & 15, cc = c & 31, ob = rr * 64 + cc * 2; return st * 1024 + (ob ^ (((ob >> 9) & 1) << 5)); }
DI void stage_rc(int b, int& R, int& C) { const int st = b / 1024, sb = b % 1024, swz = sb ^ (((sb >> 9) & 1) << 5); R = (st >> 1) * 16 + swz / 64; C = (st & 1) * 32 + (swz % 64) / 2; }
DI int perm32(int rho) { const int n = rho >> 4, i = rho & 15; return 8 * (i >> 2) + 4 * n + (i & 3); }

struct Unit { const char* A; const char* B; int pm, pn; int e, nvalid; const void* rows; };

DI unsigned cvt_pk_bf16(float lo, float hi) { unsigned r; asm volatile("v_cvt_pk_bf16_f32 %0, %1, %2" : "=v"(r) : "v"(lo), "v"(hi)); return r; }

template <class Epi, class Sched, bool GATHER>
DI void gemm_phase(LAS unsigned char* lds, const int K, const Sched& S, const Epi& E) {
    const int tid = threadIdx.x, wid = __builtin_amdgcn_readfirstlane(tid >> 6), lane = tid & 63, wr = wid >> 2, wc = wid & 3, fr = lane & 15, fq = lane >> 4;
    const int nt = K / BK;
    unsigned voffA[2], voffB[2]; int RA[2], CA[2];
#pragma unroll
    for (int i = 0; i < 2; ++i) { int R, C; stage_rc(tid * 16 + i * 8192, R, C); const int Rb = Epi::PERM ? ((R & ~31) + perm32(R & 31)) : R;
        RA[i] = R; CA[i] = C; voffA[i] = (unsigned)(R * K + C) * 2u; voffB[i] = (unsigned)(Rb * K + C) * 2u; }
    const size_t kstep = (size_t)(BK * 2);
    const size_t hstep = (size_t)HALF * K * 2;
    const unsigned ldsw = (unsigned)wid * 1024u;
    const int aoff = lds_byte(wr * 64 + fr, fq * 8), boff = lds_byte(wc * 32 + fr, fq * 8);
#define PG8_SA(b, h) (((b) * 2 + (h)) * HTB)
#define PG8_SB(b, h) ((4 + (b) * 2 + (h)) * HTB)
#define PG8_STAGE(bufoff, gbase, voff) do { _Pragma("unroll") for (int _i = 0; _i < 2; ++_i) \
        __builtin_amdgcn_global_load_lds((const unsigned*)((const char*)(gbase) + (voff)[_i]), (LAS unsigned*)(lds + (bufoff) + ldsw + _i * 8192), 16, 0, 0); } while (0)
#define PG8_LDA(dst, b, h) do { _Pragma("unroll") for (int m = 0; m < 4; ++m) _Pragma("unroll") for (int k = 0; k < 2; ++k) dst[m][k] = *(const LAS bf16x8*)(lds + PG8_SA(b, h) + aoff + m * 2048 + k * 1024); } while (0)
#define PG8_LDB(dst, b, h) do { _Pragma("unroll") for (int n = 0; n < 2; ++n) _Pragma("unroll") for (int k = 0; k < 2; ++k) dst[n][k] = *(const LAS bf16x8*)(lds + PG8_SB(b, h) + boff + n * 2048 + k * 1024); } while (0)
#define PG8_MMA(ai, bj, At, Bt) do { __builtin_amdgcn_s_setprio(1); _Pragma("unroll") for (int m = 0; m < 4; ++m) _Pragma("unroll") for (int n = 0; n < 2; ++n) _Pragma("unroll") for (int k = 0; k < 2; ++k) \
        acc[ai][bj][m][n] = __builtin_amdgcn_mfma_f32_16x16x32_bf16(Bt[n][k], At[m][k], acc[ai][bj][m][n], 0, 0, 0); __builtin_amdgcn_s_setprio(0); } while (0)
#define PG8_WAIT_V(n) asm volatile("s_waitcnt vmcnt(" #n ")" ::: "memory")
#define PG8_WAIT_L(n) asm volatile("s_waitcnt lgkmcnt(" #n ")" ::: "memory")
#define PG8_BAR __builtin_amdgcn_s_barrier()
#define PG8_SCHED __builtin_amdgcn_sched_barrier(0)
    Unit cur, nxt; int ui = 0;
    if (!S.next(0, cur)) return;
    f32x4 acc[2][2][4][2];
#pragma unroll
    for (int a = 0; a < 2; ++a)
#pragma unroll
        for (int b = 0; b < 2; ++b)
#pragma unroll
            for (int m = 0; m < 4; ++m)
#pragma unroll
                for (int n = 0; n < 2; ++n) acc[a][b][m][n] = (f32x4){0.f, 0.f, 0.f, 0.f};
    bf16x8 At[4][2], B0[2][2], B1[2][2];
    unsigned gc0[2], gc1[2], gn0[2], gn1[2];
    if (GATHER) { S.row_offs(cur, RA, CA, K, gc0, gc1); asm volatile("" : "+v"(gc0[0]), "+v"(gc0[1]), "+v"(gc1[0]), "+v"(gc1[1])); }
    const char* cA = cur.A; const char* cB = cur.B;
    const size_t hA = GATHER ? 0 : hstep;
    PG8_STAGE(PG8_SB(0, 0), cB, voffB);
    if (GATHER) PG8_STAGE(PG8_SA(0, 0), cA, gc0); else PG8_STAGE(PG8_SA(0, 0), cA, voffA);
    PG8_STAGE(PG8_SB(0, 1), cB + hstep, voffB);
    if (GATHER) PG8_STAGE(PG8_SA(0, 1), cA, gc1); else PG8_STAGE(PG8_SA(0, 1), cA + hstep, voffA);
    if (wr == 1) PG8_BAR;
    PG8_WAIT_V(4); PG8_BAR;
    PG8_STAGE(PG8_SB(1, 0), cB + kstep, voffB);
    if (GATHER) PG8_STAGE(PG8_SA(1, 0), cA + kstep, gc0); else PG8_STAGE(PG8_SA(1, 0), cA + kstep, voffA);
    PG8_STAGE(PG8_SB(1, 1), cB + hstep + kstep, voffB);
    PG8_WAIT_V(6); PG8_BAR;
    for (;;) {
        const bool has_next = S.next(ui + 1, nxt);
        const char* nA = has_next ? nxt.A : cA; const char* nB = has_next ? nxt.B : cB;
        if (GATHER) {
            if (has_next) S.row_offs(nxt, RA, CA, K, gn0, gn1); else { gn0[0] = gc0[0]; gn0[1] = gc0[1]; gn1[0] = gc1[0]; gn1[1] = gc1[1]; }
            asm volatile("" : "+v"(gn0[0]), "+v"(gn0[1]), "+v"(gn1[0]), "+v"(gn1[1]));
        }
        for (int t = 0; t < nt; t += 2) {
            const bool last = (t == nt - 2);
            const char* a1 = cA + (size_t)(t + 1) * kstep;
            const char* a2 = last ? nA : cA + (size_t)(t + 2) * kstep; const char* b2 = last ? nB : cB + (size_t)(t + 2) * kstep;
            const char* a3 = a2 + kstep; const char* b3 = b2 + kstep;
            unsigned g20[2], g21[2];
            if (GATHER) { g20[0] = last ? gn0[0] : gc0[0]; g20[1] = last ? gn0[1] : gc0[1]; g21[0] = last ? gn1[0] : gc1[0]; g21[1] = last ? gn1[1] : gc1[1]; }
            PG8_LDB(B0, 0, 0); PG8_SCHED; PG8_LDA(At, 0, 0);
            if (GATHER) PG8_STAGE(PG8_SA(1, 1), a1, gc1); else PG8_STAGE(PG8_SA(1, 1), a1 + hstep, voffA);
            PG8_WAIT_L(8); PG8_BAR; PG8_WAIT_L(0); PG8_MMA(0, 0, At, B0); PG8_BAR; PG8_SCHED;
            PG8_LDB(B1, 0, 1); PG8_STAGE(PG8_SB(0, 0), b2, voffB);
            PG8_BAR; PG8_WAIT_L(0); PG8_MMA(0, 1, At, B1); PG8_BAR;
            PG8_LDA(At, 0, 1);
            if (GATHER) PG8_STAGE(PG8_SA(0, 0), a2, g20); else PG8_STAGE(PG8_SA(0, 0), a2, voffA);
            PG8_BAR; PG8_WAIT_L(0); PG8_MMA(1, 0, At, B0); PG8_BAR; PG8_SCHED;
            PG8_STAGE(PG8_SB(0, 1), b2 + hstep, voffB);
            PG8_WAIT_V(6); PG8_BAR; PG8_MMA(1, 1, At, B1); PG8_BAR;
            PG8_LDB(B0, 1, 0); PG8_SCHED; PG8_LDA(At, 1, 0);
            if (GATHER) PG8_STAGE(PG8_SA(0, 1), a2, g21); else PG8_STAGE(PG8_SA(0, 1), a2 + hstep, voffA);
            PG8_WAIT_L(8); PG8_BAR; PG8_WAIT_L(0); PG8_MMA(0, 0, At, B0); PG8_BAR; PG8_SCHED;
            PG8_LDB(B1, 1, 1); PG8_STAGE(PG8_SB(1, 0), b3, voffB);
            PG8_BAR; PG8_WAIT_L(0); PG8_MMA(0, 1, At, B1); PG8_BAR;
            PG8_LDA(At, 1, 1);
            if (GATHER) PG8_STAGE(PG8_SA(1, 0), a3, g20); else PG8_STAGE(PG8_SA(1, 0), a3, voffA);
            PG8_BAR; PG8_WAIT_L(0); PG8_MMA(1, 0, At, B0); PG8_BAR; PG8_SCHED;
            PG8_STAGE(PG8_SB(1, 1), b3 + hstep, voffB);
            PG8_WAIT_V(6); PG8_BAR; PG8_MMA(1, 1, At, B1); PG8_BAR;
        }
        { int tz = threadIdx.x; asm volatile("" : "+v"(tz));
          const int ewid = tz >> 6, elane = tz & 63; E(acc, cur, ewid >> 2, ewid & 3, elane & 15, elane >> 4); }
        if (!has_next) break;
#pragma unroll
        for (int a = 0; a < 2; ++a)
#pragma unroll
            for (int b = 0; b < 2; ++b)
#pragma unroll
                for (int m = 0; m < 4; ++m)
#pragma unroll
                    for (int n = 0; n < 2; ++n) acc[a][b][m][n] = (f32x4){0.f, 0.f, 0.f, 0.f};
        cur = nxt; cA = nA; cB = nB; ++ui;
        if (GATHER) { gc0[0] = gn0[0]; gc0[1] = gn0[1]; gc1[0] = gn1[0]; gc1[1] = gn1[1]; }
    }
    PG8_WAIT_V(0);
    if (wr == 0) PG8_BAR;
    PG8_BAR;
    (void)hA;
#undef PG8_SA
#undef PG8_SB
#undef PG8_STAGE
#undef PG8_LDA
#undef PG8_LDB
#undef PG8_MMA
#undef PG8_WAIT_V
#undef PG8_WAIT_L
#undef PG8_BAR
#undef PG8_SCHED
}
}

struct DenseSched {
    const char* A; const char* B; int K, nM, nN, nwg, G, c;
    DI void init(const void* A_, const void* B_, int Mrows, int N, int K_, int G_, int c_) { A = (const char*)A_; B = (const char*)B_; K = K_; nM = Mrows / 256; nN = N / 256; nwg = nM * nN; G = G_; c = c_; }
    DI bool next(int i, pg8::Unit& u) const {
        const int L = i * G + c; if (L >= nwg) return false;
        int wgid = L; { const int q = nwg / 8, r = nwg % 8, xcd = wgid % 8, off = wgid / 8; wgid = (xcd < r ? xcd * (q + 1) : r * (q + 1) + (xcd - r) * q) + off; }
        const int nig = 8 * nN, gid = wgid / nig, fm = gid * 8, gsz = (nM - fm) < 8 ? (nM - fm) : 8;
        u.pm = fm + ((wgid % nig) % gsz); u.pn = (wgid % nig) / gsz;
        u.A = A + (size_t)u.pm * 256 * K * 2; u.B = B + (size_t)u.pn * 256 * K * 2; u.e = 0; u.nvalid = 256; u.rows = nullptr; return true;
    }
    DI void row_offs(const pg8::Unit&, const int*, const int*, int, unsigned*, unsigned*) const {}
};
struct MoeSched {
    const char* A; const char* B; int K, NJ, BR, G, c, gather;
    const LAS int* tstart;
    const int* cnt; const char* list;
    DI bool next(int i, pg8::Unit& u) const {
        const int L = i * G + c; const int ttot = __builtin_amdgcn_readfirstlane(tstart[32]); if (L >= ttot * NJ) return false;
        const int tau = L / NJ, j = L % NJ;
        int e = 0;
        for (int q = 1; q < 32; ++q) e += (__builtin_amdgcn_readfirstlane(tstart[q]) <= tau) ? 1 : 0;
        const int lt = tau - __builtin_amdgcn_readfirstlane(tstart[e]);
        int nv = __builtin_amdgcn_readfirstlane(cnt[e]) - lt * 256; nv = nv > 256 ? 256 : nv;
        u.pm = tau; u.pn = j; u.e = e; u.nvalid = nv; u.rows = list + ((size_t)e * 16384 + (size_t)lt * 256) * 16;
        u.A = gather ? A : A + (size_t)tau * 256 * K * 2;
        u.B = B + ((size_t)e * BR + (size_t)j * 256) * K * 2; return true;
    }
    DI void row_offs(const pg8::Unit& u, const int* RA, const int* CA, int K_, unsigned* g0, unsigned* g1) const {
#pragma unroll
        for (int i = 0; i < 2; ++i) {
            const int r0 = RA[i], r1 = RA[i] + 128;
            int t0 = *(const int*)((const char*)u.rows + (size_t)r0 * 16), t1 = *(const int*)((const char*)u.rows + (size_t)r1 * 16);
            t0 = (r0 < u.nvalid) ? (t0 >> 1) : 0; t1 = (r1 < u.nvalid) ? (t1 >> 1) : 0;
            g0[i] = (unsigned)(t0 * K_ + CA[i]) * 2u; g1[i] = (unsigned)(t1 * K_ + CA[i]) * 2u;
        }
    }
};

struct EpiProj {
    static constexpr bool PERM = true;
    bf16_t* base; const float* rstd;
    DI void operator()(const f32x4 (&acc)[2][2][4][2], const pg8::Unit& u, int wr, int wc, int fr, int fq) const {
        const int colt = u.pn * 256; bf16_t* o = base + (size_t)(colt >> 10) * (PROJ_STRIDE / 2);
        const int col0 = (colt & 1023) + wc * 32 + 8 * fq, row0 = u.pm * 256 + wr * 64 + fr;
#pragma unroll
        for (int ai = 0; ai < 2; ++ai)
#pragma unroll
            for (int m = 0; m < 4; ++m) { bf16_t* rowp = o + (size_t)(row0 + ai * 128 + m * 16) * 1024 + col0; const float s = rstd[row0 + ai * 128 + m * 16];
#pragma unroll
                for (int bj = 0; bj < 2; ++bj) { const f32x4 v0 = acc[ai][bj][m][0] * s, v1 = acc[ai][bj][m][1] * s; u32x4 w;
                    w.x = pg8::cvt_pk_bf16(v0[0], v0[1]); w.y = pg8::cvt_pk_bf16(v0[2], v0[3]); w.z = pg8::cvt_pk_bf16(v1[0], v1[1]); w.w = pg8::cvt_pk_bf16(v1[2], v1[3]);
                    *(u32x4*)(rowp + bj * 128) = w; } }
    }
};
struct EpiX1 {
    static constexpr bool PERM = false;
    const float* x; float* x1;
    DI void operator()(const f32x4 (&acc)[2][2][4][2], const pg8::Unit& u, int wr, int wc, int fr, int fq) const {
        const int row0 = u.pm * 256 + wr * 64 + fr, col0 = u.pn * 256 + wc * 32 + 4 * fq;
#pragma unroll
        for (int ai = 0; ai < 2; ++ai)
#pragma unroll
            for (int m = 0; m < 4; ++m) { const size_t off = (size_t)(row0 + ai * 128 + m * 16) * D + col0;
#pragma unroll
                for (int bj = 0; bj < 2; ++bj)
#pragma unroll
                    for (int n = 0; n < 2; ++n) { const f32x4 xv = *(const f32x4*)(x + off + bj * 128 + n * 16); *(f32x4*)(x1 + off + bj * 128 + n * 16) = xv + acc[ai][bj][m][n]; } }
    }
};
struct EpiUp {
    static constexpr bool PERM = true;
    bf16_t* hb;
    DI void operator()(const f32x4 (&acc)[2][2][4][2], const pg8::Unit& u, int wr, int wc, int fr, int fq) const {
        const int col0 = u.pn * 128 + wc * 32 + 8 * fq;
#pragma unroll
        for (int ai = 0; ai < 2; ++ai)
#pragma unroll
            for (int m = 0; m < 4; ++m) { const int r = ai * 128 + wr * 64 + m * 16 + fr;
                const float s = *(const float*)((const char*)u.rows + (size_t)r * 16 + 4);
                float h[8];
#pragma unroll
                for (int n = 0; n < 2; ++n)
#pragma unroll
                    for (int e = 0; e < 4; ++e) { const float a1 = s * acc[ai][0][m][n][e], a3 = s * acc[ai][1][m][n][e]; h[n * 4 + e] = siluf_(a1) * a3; }
                u32x4 w; w.x = pg8::cvt_pk_bf16(h[0], h[1]); w.y = pg8::cvt_pk_bf16(h[2], h[3]); w.z = pg8::cvt_pk_bf16(h[4], h[5]); w.w = pg8::cvt_pk_bf16(h[6], h[7]);
                *(u32x4*)(hb + (size_t)(u.pm * 256 + r) * FF + col0) = w; }
    }
};
struct EpiDown {
    static constexpr bool PERM = true;
    bf16_t* y2;
    DI void operator()(const f32x4 (&acc)[2][2][4][2], const pg8::Unit& u, int wr, int wc, int fr, int fq) const {
        const int col0 = u.pn * 256 + wc * 32 + 8 * fq;
#pragma unroll
        for (int ai = 0; ai < 2; ++ai)
#pragma unroll
            for (int m = 0; m < 4; ++m) { const int r = ai * 128 + wr * 64 + m * 16 + fr;
                if (r < u.nvalid) {
                    const int t2 = *(const int*)((const char*)u.rows + (size_t)r * 16);
                    const float gt = *(const float*)((const char*)u.rows + (size_t)r * 16 + 8);
                    bf16_t* rowp = y2 + (size_t)t2 * D + col0;
#pragma unroll
                    for (int bj = 0; bj < 2; ++bj) { const f32x4 v0 = acc[ai][bj][m][0] * gt, v1 = acc[ai][bj][m][1] * gt; u32x4 w;
                        w.x = pg8::cvt_pk_bf16(v0[0], v0[1]); w.y = pg8::cvt_pk_bf16(v0[2], v0[3]); w.z = pg8::cvt_pk_bf16(v1[0], v1[1]); w.w = pg8::cvt_pk_bf16(v1[2], v1[3]);
                        *(u32x4*)(rowp + bj * 128) = w; } } }
    }
};

struct Args { const float* in[25]; float* out; unsigned char* ws; int ph_lo, ph_hi; };
enum { I_X = 0, I_NMW, I_WIN, I_GCW, I_ALOG, I_DTB, I_GNW, I_RCW, I_RCB, I_WRG, I_BRG, I_WIG, I_BIG, I_LAM, I_RNW, I_WOUT, I_NFW, I_RWG, I_RBG, I_RWE, I_RBE, I_W1, I_W3, I_W2, I_NFIN };

constexpr int LDS_STAGE = 131072, LDS_MISC = LDS_STAGE, LDS_TSTART = LDS_STAGE + 256, LDS_BYTES = 147456;

DI void transpose_item(const float* W, int ldw, bf16_t* WT, int ldt, LAS float* scr, int k0, int n0, int drow0, int lane) {
#pragma unroll 8
    for (int i = 0; i < 32; ++i) { const int kk = 2 * i + (lane >> 5); scr[kk * 33 + (lane & 31)] = W[(size_t)(k0 + kk) * ldw + n0 + (lane & 31)]; }
    asm volatile("s_waitcnt lgkmcnt(0)" ::: "memory");
    const int c = lane & 7;
#pragma unroll
    for (int j = 0; j < 4; ++j) { const int n = (lane >> 3) + 8 * j; const LAS float* s = scr + (8 * c) * 33 + n;
        u32x4 o; o.x = pk2(s[0 * 33], s[1 * 33]); o.y = pk2(s[2 * 33], s[3 * 33]); o.z = pk2(s[4 * 33], s[5 * 33]); o.w = pk2(s[6 * 33], s[7 * 33]);
        *(u32x4*)(WT + (size_t)(drow0 + n) * ldt + k0 + 8 * c) = o; }
    asm volatile("s_waitcnt lgkmcnt(0)" ::: "memory");
}

DI void p0_weights(const Args& a, LAS unsigned char* lds, int gw, int NGW, int wave, int lane) {
    LAS float* scr = (LAS float*)(lds + wave * 16384);
    unsigned char* ws = a.ws;
    constexpr int S0 = 32 * 128, S1 = 32 * 64, S2 = 32 * 64, S3 = 32 * 512, S4 = S3, S5 = 32 * 512, S6 = 64, S7 = 64;
    constexpr int NITEMS = S0 + S1 + S2 + S3 + S4 + S5 + S6 + S7;
    for (int it = gw; it < NITEMS; it += NGW) {
        int r = it;
        if (r < S0) { const int kb = r / 128, nb = r % 128; transpose_item(a.in[I_WIN], INCOLS, (bf16_t*)(ws + WS_WIN), D, scr, kb * 64, nb * 32, nb * 32, lane); continue; } r -= S0;
        if (r < S1) { const int kb = r / 64, nb = r % 64; transpose_item(a.in[I_WIN] + 4112, INCOLS, (bf16_t*)(ws + WS_WIN), D, scr, kb * 64, nb * 32, 4096 + nb * 32, lane); continue; } r -= S1;
        if (r < S2) { const int kb = r / 64, nb = r % 64; transpose_item(a.in[I_WOUT], D, (bf16_t*)(ws + WS_WOUT), D, scr, kb * 64, nb * 32, nb * 32, lane); continue; } r -= S2;
        if (r < S3 + S4) { const int w3 = r >= S3; if (w3) r -= S3; const int e = r / 512, q = r % 512, kb = q / 16, nb = q % 16, n0 = nb * 32;
            const int drow = (n0 >> 7) * 256 + (n0 & 127) + (w3 ? 128 : 0);
            transpose_item(a.in[w3 ? I_W3 : I_W1] + (size_t)e * D * FF, FF, (bf16_t*)(ws + WS_W13) + (size_t)e * 1024 * D, D, scr, kb * 64, n0, drow, lane); continue; } r -= S3 + S4;
        if (r < S5) { const int e = r / 512, q = r % 512, kb = q / 64, nb = q % 64;
            transpose_item(a.in[I_W2] + (size_t)e * FF * D, D, (bf16_t*)(ws + WS_W2) + (size_t)e * D * FF, FF, scr, kb * 64, nb * 32, nb * 32, lane); continue; } r -= S5;
        { const int ig = r >= S6; if (ig) r -= S6; const int n = r / 8, q = r % 8, kb = q / 4, nb = q % 4;
            transpose_item(a.in[ig ? I_WIG : I_WRG] + (size_t)n * 128 * 128, 128, (bf16_t*)(ws + WS_WG) + (size_t)n * 256 * 128, 128, scr, kb * 64, nb * 32, nb * 32 + (ig ? 128 : 0), lane); }
    }
}

typedef float f32x4v __attribute__((ext_vector_type(4)));
template <int MODE>
DI void row_pass16(const Args& a, const float* X, const float* wn, bf16_t* XNb, float* RSTD, int row0, int lane, LAS float* lg  ) {
    constexpr int NT = MODE == 0 ? 1 : 3;
    const int c = lane & 15, g = lane >> 4;
    f32x4 acc[NT];
#pragma unroll
    for (int t = 0; t < NT; ++t) acc[t] = (f32x4){0.f, 0.f, 0.f, 0.f};
    float ss = 0.f;
    const float* xr = X + (size_t)(row0 + c) * D + 8 * g;
    bf16_t* xo = XNb + (size_t)(row0 + c) * D + 8 * g;
    const float* wsm0 = MODE == 0 ? a.in[I_WIN] + 4096 + c : a.in[I_RWE] + c;
    const float* wgrp = a.in[I_RWG] + (c < 4 ? c : 0);
    for (int S = 0; S < 64; ++S) {
        f32x4 x0 = *(const f32x4*)(xr + 32 * S), x1 = *(const f32x4*)(xr + 32 * S + 4);
        const f32x4 w0 = *(const f32x4*)(wn + 32 * S + 8 * g), w1 = *(const f32x4*)(wn + 32 * S + 8 * g + 4);
        ss += (x0[0] * x0[0] + x0[1] * x0[1]) + (x0[2] * x0[2] + x0[3] * x0[3]) + (x1[0] * x1[0] + x1[1] * x1[1]) + (x1[2] * x1[2] + x1[3] * x1[3]);
        x0 = x0 * w0; x1 = x1 * w1;
        u32x4 o; o.x = pk2(x0[0], x0[1]); o.y = pk2(x0[2], x0[3]); o.z = pk2(x1[0], x1[1]); o.w = pk2(x1[2], x1[3]);
        *(u32x4*)(xo + 32 * S) = o;
#pragma unroll
        for (int e = 0; e < 8; ++e) {
            const int k = 32 * S + 8 * g + e; const float av = e < 4 ? x0[e & 3] : x1[e & 3];
            if (MODE == 0) { const float b = wsm0[(size_t)k * INCOLS]; acc[0] = __builtin_amdgcn_mfma_f32_16x16x4f32(av, b, acc[0], 0, 0, 0); }
            else { const float b0 = wsm0[(size_t)k * 32], b1 = wsm0[(size_t)k * 32 + 16]; float b2 = wgrp[(size_t)k * 4]; b2 = c < 4 ? b2 : 0.f;
                acc[0] = __builtin_amdgcn_mfma_f32_16x16x4f32(av, b0, acc[0], 0, 0, 0); acc[1] = __builtin_amdgcn_mfma_f32_16x16x4f32(av, b1, acc[1], 0, 0, 0);
                if (NT > 2) acc[NT - 1] = __builtin_amdgcn_mfma_f32_16x16x4f32(av, b2, acc[NT - 1], 0, 0, 0); }
        }
    }
    ss += __shfl_xor(ss, 16); ss += __shfl_xor(ss, 32);
    const float rstd = rsqrtf(ss * (1.f / D) + EPS);
    if (g == 0) RSTD[row0 + c] = rstd;
    float rs[4];
#pragma unroll
    for (int r = 0; r < 4; ++r) rs[r] = __shfl(rstd, 4 * g + r);
    if (MODE == 0) {
        const int hh = c & 7; const float al = __expf(a.in[I_ALOG][hh]), dtb = a.in[I_DTB][hh];
        float* BETA = (float*)(a.ws + WS_BETA); float* GG = (float*)(a.ws + WS_G);
#pragma unroll
        for (int r = 0; r < 4; ++r) { const float v = rs[r] * acc[0][r]; const int row = row0 + 4 * g + r;
            if (c < 8) BETA[(size_t)row * 8 + hh] = sigmoidf_(v); else GG[(size_t)row * 8 + hh] = -al * softplusf_(v + dtb); }
    } else {
        const float be0 = a.in[I_RBE][c], be1 = a.in[I_RBE][16 + c], bg = a.in[I_RBG][c < 4 ? c : 0];
#pragma unroll
        for (int r = 0; r < 4; ++r) { const int rr = 4 * g + r; lg[rr * 40 + c] = rs[r] * acc[0][r] + be0; lg[rr * 40 + 16 + c] = rs[r] * acc[1][r] + be1; if (c < 4) lg[rr * 40 + 32 + c] = rs[r] * acc[NT - 1][r] + bg; }
        asm volatile("s_waitcnt lgkmcnt(0)" ::: "memory");
        if (lane < 16) {
            const LAS float* L = lg + lane * 40; const int token = row0 + lane;
            float gm = L[32]; int gi = 0;
#pragma unroll
            for (int q = 1; q < 4; ++q) if (L[32 + q] > gm) { gm = L[32 + q]; gi = q; }
            float gs = 0.f;
#pragma unroll
            for (int q = 0; q < 4; ++q) gs += __expf(L[32 + q] - gm);
            const float gp = 1.f / gs;
            float ev[8];
#pragma unroll
            for (int q = 0; q < 8; ++q) ev[q] = L[gi * 8 + q];
            float m1 = ev[0]; int i1 = 0;
#pragma unroll
            for (int q = 1; q < 8; ++q) if (ev[q] > m1) { m1 = ev[q]; i1 = q; }
            float m2 = -3.0e38f; int i2 = 0;
#pragma unroll
            for (int q = 0; q < 8; ++q) if (q != i1 && ev[q] > m2) { m2 = ev[q]; i2 = q; }
            const float p2 = __expf(m2 - m1), den = 1.f / (1.f + p2);
            const float g1 = gp * den, g2 = gp * p2 * den;
            int* cnt = (int*)(a.ws + WS_CTL) + CW_CNT; const float myr = rstd;
            const int e1 = gi * 8 + i1, e2 = gi * 8 + i2;
            const int s1 = atomicAdd(cnt + e1, 1), s2 = atomicAdd(cnt + e2, 1);
            f32x4* l1 = (f32x4*)(a.ws + WS_LIST + ((size_t)e1 * 16384 + s1) * 16); f32x4* l2 = (f32x4*)(a.ws + WS_LIST + ((size_t)e2 * 16384 + s2) * 16);
            *l1 = (f32x4){__int_as_float(token * 2), myr, g1, 0.f}; *l2 = (f32x4){__int_as_float(token * 2 + 1), myr, g2, 0.f};
        }
        asm volatile("s_waitcnt lgkmcnt(0)" ::: "memory");
    }
}

DI void final_row(const float* x1, const bf16_t* y2, const float* w, float* out, int row, int lane) {
    const f32x4* xr = (const f32x4*)(x1 + (size_t)row * D) + lane;
    const u32x2* ya = (const u32x2*)(y2 + (size_t)(2 * row) * D) + lane; const u32x2* yb = (const u32x2*)(y2 + (size_t)(2 * row + 1) * D) + lane;
    f32x4 v[8]; float ss = 0.f;
#pragma unroll
    for (int j = 0; j < 8; ++j) { const f32x4 x = xr[64 * j]; const u32x2 p = ya[64 * j], q = yb[64 * j];
        v[j] = (f32x4){x[0] + bflo(p.x) + bflo(q.x), x[1] + bfhi(p.x) + bfhi(q.x), x[2] + bflo(p.y) + bflo(q.y), x[3] + bfhi(p.y) + bfhi(q.y)};
        ss += (v[j][0] * v[j][0] + v[j][1] * v[j][1]) + (v[j][2] * v[j][2] + v[j][3] * v[j][3]); }
    const float rstd = rsqrtf(wave_sum(ss) * (1.f / D) + EPS);
    f32x4* o = (f32x4*)(out + (size_t)row * D) + lane; const f32x4* wr = (const f32x4*)w + lane;
#pragma unroll
    for (int j = 0; j < 8; ++j) o[64 * j] = v[j] * rstd * wr[64 * j];
}

__global__ void __launch_bounds__(NTHREADS, 2) fwd(Args a) {
    extern __shared__ __attribute__((aligned(16))) unsigned char lds_raw[];
    LAS unsigned char* lds = (LAS unsigned char*)lds_raw;
    const int tid = threadIdx.x, lane = tid & 63, wave = __builtin_amdgcn_readfirstlane(tid >> 6);
    const int G = gridDim.x, bx = blockIdx.x;
    const int vcu = (G % 8 == 0) ? (bx % 8) * (G / 8) + bx / 8 : bx;
    const int gw = vcu * NWAVES + wave, NGW = G * NWAVES;
    unsigned char* ws = a.ws;
    const int lo = a.ph_lo, hi = a.ph_hi;
#define IN(k) (lo <= (k) && (k) < hi)
    if (IN(0)) {
        p0_weights(a, lds, gw, NGW, wave, lane);
        for (int task = gw; task < M / 16; task += NGW) row_pass16<0>(a, a.in[I_X], a.in[I_NMW], (bf16_t*)(ws + WS_XN), (float*)(ws + WS_RSTD1), task * 16, lane, nullptr);
    }
    if (IN(1)) {
        DenseSched S; S.init(ws + WS_XN, ws + WS_WIN, M, NPROJ, D, G, bx);
        EpiProj E{(bf16_t*)(ws + WS_PROJ), (const float*)(ws + WS_RSTD1)};
        pg8::gemm_phase<EpiProj, DenseSched, false>(lds, D, S, E);
    }
    if (IN(3)) {
        DenseSched S; S.init(ws + WS_MIX, ws + WS_WOUT, M, D, D, G, bx);
        EpiX1 E{a.in[I_X], (float*)(ws + WS_X1)};
        pg8::gemm_phase<EpiX1, DenseSched, false>(lds, D, S, E);
    }
    if (IN(4)) {
        LAS float* lg = (LAS float*)(lds + wave * 4096);
        for (int task = gw; task < M / 16; task += NGW) row_pass16<1>(a, (const float*)(ws + WS_X1), a.in[I_NFW], (bf16_t*)(ws + WS_H2), (float*)(ws + WS_RSTD2), task * 16, lane, lg);
    }
    if (IN(5) || IN(6)) {
        LAS int* tstart = (LAS int*)(lds + LDS_TSTART);
        const int* cnt = (const int*)(ws + WS_CTL) + CW_CNT;
        if (wave == 0) { const int cn = lane < 32 ? cnt[lane] : 0; const int ntl = (cn + 255) >> 8; int incl = ntl;
#pragma unroll
            for (int o = 1; o < 32; o <<= 1) { const int v = __shfl_up(incl, o); if (lane >= o) incl += v; }
            if (lane < 32) tstart[lane] = incl - ntl; if (lane == 31) tstart[32] = incl; }
        __syncthreads();
        if (IN(5)) {
            MoeSched S{(const char*)(ws + WS_H2), (const char*)(ws + WS_W13), D, 4, 1024, G, bx, 1, tstart, cnt, (const char*)(ws + WS_LIST)};
            EpiUp E{(bf16_t*)(ws + WS_HB)};
            pg8::gemm_phase<EpiUp, MoeSched, true>(lds, D, S, E);
        }
        if (IN(6)) {
            MoeSched S{(const char*)(ws + WS_HB), (const char*)(ws + WS_W2), FF, 8, 2048, G, bx, 0, tstart, cnt, (const char*)(ws + WS_LIST)};
            EpiDown E{(bf16_t*)(ws + WS_Y2)};
            pg8::gemm_phase<EpiDown, MoeSched, false>(lds, FF, S, E);
        }
    }
    if (IN(7)) {
        for (int row = gw; row < M; row += NGW) final_row((const float*)(ws + WS_X1), (const bf16_t*)(ws + WS_Y2), a.in[I_NFIN], a.out, row, lane);
    }
#undef IN
}

__global__ void __launch_bounds__(512) naive_gdn(Args a) {
    __shared__ float sq[16][128], sk[16][128], sv[16][128];
    __shared__ float red[4][128], red2[4][128];
    const int bh = blockIdx.x, b = bh >> 3, h = bh & 7, tid = threadIdx.x, lane = tid & 63, wave = tid >> 6;
    const bf16_t* P = (const bf16_t*)(a.ws + WS_PROJ);
    const float* gcw = a.in[I_GCW]; const float* BETA = (const float*)(a.ws + WS_BETA); const float* GG = (const float*)(a.ws + WS_G);
    float* ORAW = (float*)(a.ws + WS_ORAW);
    const int dvi = tid & 127, dkg = tid >> 7;
    float S[32];
#pragma unroll
    for (int j = 0; j < 32; ++j) S[j] = 0.f;
    for (int t0 = 0; t0 < T; t0 += 16) {
        for (int idx = tid; idx < 16 * 384; idx += 512) {
            const int tok = idx / 384, ch = idx % 384, which = ch >> 7, d = ch & 127, col = h * 128 + d, tt = t0 + tok;
            const bf16_t* src = P + (size_t)which * (PROJ_STRIDE / 2);
            float acc = 0.f;
#pragma unroll
            for (int j = 0; j < 4; ++j) { const int ts = tt - 3 + j; if (ts >= 0) acc += gcw[j * 3072 + which * 1024 + col] * bf2f(src[(size_t)(b * T + ts) * 1024 + col]); }
            const float v = siluf_(acc);
            if (which == 0) sq[tok][d] = v; else if (which == 1) sk[tok][d] = v; else sv[tok][d] = v;
        }
        __syncthreads();
        for (int q = wave; q < 32; q += 8) { const int tok = q >> 1; float* p = (q & 1) ? sk[tok] : sq[tok];
            const float v0 = p[lane], v1 = p[lane + 64]; const float ss = wave_sum(v0 * v0 + v1 * v1);
            const float sc = rsqrtf(ss + EPS) * ((q & 1) ? 1.f : 0.08838834764831845f); p[lane] = v0 * sc; p[lane + 64] = v1 * sc; }
        __syncthreads();
        for (int tok = 0; tok < 16; ++tok) {
            const size_t row = (size_t)b * T + t0 + tok;
            const float eg = __expf(GG[row * 8 + h]), bt = BETA[row * 8 + h];
            float p = 0.f;
#pragma unroll
            for (int j = 0; j < 32; ++j) { S[j] *= eg; p += S[j] * sk[tok][dkg * 32 + j]; }
            red[dkg][dvi] = p;
            __syncthreads();
            const float kv = (red[0][dvi] + red[1][dvi]) + (red[2][dvi] + red[3][dvi]);
            const float delta = bt * (sv[tok][dvi] - kv);
            float po = 0.f;
#pragma unroll
            for (int j = 0; j < 32; ++j) { S[j] += sk[tok][dkg * 32 + j] * delta; po += S[j] * sq[tok][dkg * 32 + j]; }
            red2[dkg][dvi] = po;
            __syncthreads();
            if (dkg == 0) ORAW[row * 1024 + h * 128 + dvi] = (red2[0][dvi] + red2[1][dvi]) + (red2[2][dvi] + red2[3][dvi]);
        }
        __syncthreads();
    }
}
__global__ void __launch_bounds__(256) naive_gdn_final(Args a) {
    const int gwv = blockIdx.x * 4 + (threadIdx.x >> 6), lane = threadIdx.x & 63; if (gwv >= M * 8) return;
    const int row = gwv >> 3, h = gwv & 7;
    const float* o = (const float*)(a.ws + WS_ORAW) + (size_t)row * 1024 + h * 128;
    const bf16_t* z = (const bf16_t*)(a.ws + WS_PROJ + 3 * PROJ_STRIDE) + (size_t)row * 1024 + h * 128;
    bf16_t* mix = (bf16_t*)(a.ws + WS_MIX) + (size_t)row * D + h * 128;
    const float v0 = o[lane], v1 = o[lane + 64]; const float rstd = rsqrtf(wave_sum(v0 * v0 + v1 * v1) * (1.f / 128.f) + EPS);
    mix[lane] = (bf16_t)f2bf(v0 * rstd * a.in[I_GNW][lane] * siluf_(bf2f(z[lane])));
    mix[lane + 64] = (bf16_t)f2bf(v1 * rstd * a.in[I_GNW][lane + 64] * siluf_(bf2f(z[lane + 64])));
}
__global__ void __launch_bounds__(256) naive_rg_gates(Args a) {
    __shared__ float xc[16][128];
    const int n = blockIdx.x & 7, r0 = (blockIdx.x >> 3) * 16, tid = threadIdx.x;
    const bf16_t* RX = (const bf16_t*)(a.ws + WS_PROJ + 4 * PROJ_STRIDE);
    float* RA = (float*)(a.ws + WS_RGA); float* RB = (float*)(a.ws + WS_RGB);
    for (int idx = tid; idx < 2048; idx += 256) { const int tok = idx >> 7, i = idx & 127, ch = n * 128 + i, row = r0 + tok, t = row % T;
        float acc = a.in[I_RCB][ch];
#pragma unroll
        for (int j = 0; j < 4; ++j) { const int ts = t - 3 + j; if (ts >= 0) acc += a.in[I_RCW][j * 1024 + ch] * bf2f(RX[(size_t)(row - 3 + j) * 1024 + ch]); }
        xc[tok][i] = acc; }
    __syncthreads();
    const int j = tid & 127, half = tid >> 7, ch = n * 128 + j;
    const float* Wr = a.in[I_WRG] + (size_t)n * 16384; const float* Wi = a.in[I_WIG] + (size_t)n * 16384;
    const float sp = softplusf_(-a.in[I_LAM][ch]);
    for (int tok = half * 8; tok < half * 8 + 8; ++tok) {
        float ar = a.in[I_BRG][ch], ai = a.in[I_BIG][ch];
        for (int i = 0; i < 128; ++i) { const float x = xc[tok][i]; ar += x * Wr[i * 128 + j]; ai += x * Wi[i * 128 + j]; }
        const float r = sigmoidf_(ar), ig = sigmoidf_(ai), la = -8.f * r * sp, av = __expf(la), mult = sqrtf(-expm1f(2.f * la));
        RA[(size_t)(r0 + tok) * 1024 + ch] = av; RB[(size_t)(r0 + tok) * 1024 + ch] = mult * ig * xc[tok][j]; }
}
__global__ void __launch_bounds__(256) naive_rg_scan(Args a) {
    const int id = blockIdx.x * 256 + threadIdx.x, b = id >> 10, ch = id & 1023;
    float* RA = (float*)(a.ws + WS_RGA); const float* RB = (const float*)(a.ws + WS_RGB);
    const bf16_t* RG = (const bf16_t*)(a.ws + WS_PROJ + 5 * PROJ_STRIDE);
    float h = 0.f;
    for (int t = 0; t < T; ++t) { const size_t o = (size_t)(b * T + t) * 1024 + ch; h = RA[o] * h + RB[o]; RA[o] = h * gelu_tanh(bf2f(RG[o])); }
}
__global__ void __launch_bounds__(256) naive_rg_norm(Args a) {
    const int gwv = blockIdx.x * 4 + (threadIdx.x >> 6), lane = threadIdx.x & 63; if (gwv >= M * 8) return;
    const int row = gwv >> 3, n = gwv & 7;
    const float* y = (const float*)(a.ws + WS_RGA) + (size_t)row * 1024 + n * 128;
    bf16_t* mix = (bf16_t*)(a.ws + WS_MIX) + (size_t)row * D + 1024 + n * 128;
    const float v0 = y[lane], v1 = y[lane + 64]; const float rstd = rsqrtf(wave_sum(v0 * v0 + v1 * v1) * (1.f / 128.f) + EPS);
    mix[lane] = (bf16_t)f2bf(v0 * rstd * a.in[I_RNW][n * 128 + lane]); mix[lane + 64] = (bf16_t)f2bf(v1 * rstd * a.in[I_RNW][n * 128 + lane + 64]);
}

extern "C" void kernel_launch(void* const* d_in, const int* in_sizes, int n_in, void* d_out, int out_size, void* d_ws, size_t ws_size, hipStream_t stream) {
    static int grid = 0;
    if (grid == 0) {
        if (n_in != 25 || ws_size < WS_END) { fprintf(stderr, "kernel_launch: unexpected n_in %d or ws_size %zu (< %zu)\n", n_in, ws_size, (size_t)WS_END); grid = -1; return; }
        int dev = 0, cus = 0; hipGetDevice(&dev); hipDeviceGetAttribute(&cus, hipDeviceAttributeMultiprocessorCount, dev);
        if (hipFuncSetAttribute((const void*)fwd, hipFuncAttributeMaxDynamicSharedMemorySize, LDS_BYTES) != hipSuccess) { fprintf(stderr, "kernel_launch: hipFuncSetAttribute failed\n"); grid = -1; return; }
        int per_cu = 0; hipOccupancyMaxActiveBlocksPerMultiprocessor(&per_cu, (const void*)fwd, NTHREADS, LDS_BYTES); (void)hipGetLastError();
        grid = cus > 0 ? cus : 256;
    }
    if (grid < 0) return;
    hipMemsetAsync((char*)d_ws + WS_CTL, 0, CTL_BYTES, stream);
    Args a{};
    for (int i = 0; i < 25; ++i) a.in[i] = (const float*)d_in[i];
    a.out = (float*)d_out; a.ws = (unsigned char*)d_ws;
    auto run = [&](int lo, int hi) { a.ph_lo = lo; a.ph_hi = hi; hipLaunchKernelGGL(fwd, dim3(grid), dim3(NTHREADS), LDS_BYTES, stream, a); };
    run(0, 1); run(1, 2);
    a.ph_lo = 0; a.ph_hi = 0;
    hipLaunchKernelGGL(naive_gdn, dim3(16), dim3(512), 0, stream, a);
    hipLaunchKernelGGL(naive_gdn_final, dim3(M * 8 / 4), dim3(256), 0, stream, a);
    hipLaunchKernelGGL(naive_rg_gates, dim3((M / 16) * 8), dim3(256), 0, stream, a);
    hipLaunchKernelGGL(naive_rg_scan, dim3(8), dim3(256), 0, stream, a);
    hipLaunchKernelGGL(naive_rg_norm, dim3(M * 8 / 4), dim3(256), 0, stream, a);
    run(3, 4); run(4, 5); run(5, 6); run(6, 7); run(7, 8);
}
```

```cpp
#include <hip/hip_runtime.h>
#include <cstdio>
#include <cstdint>

#define DI __device__ __forceinline__
#define LAS __attribute__((address_space(3)))
typedef unsigned short bf16_t;
typedef short bf16x8 __attribute__((ext_vector_type(8)));
typedef float f32x4 __attribute__((ext_vector_type(4)));
typedef float f32x2 __attribute__((ext_vector_type(2)));
typedef unsigned u32x4 __attribute__((ext_vector_type(4)));
typedef unsigned u32x2 __attribute__((ext_vector_type(2)));

constexpr int NB = 2, T = 8192, M = NB * T, D = 2048;
constexpr int NH = 8, HD = 128, GW = 1024, RW = 1024, RGB = 8, RBD = 128;
constexpr int NE = 32, NG = 4, EPG = 8, FF = 512;
constexpr int INCOLS = 6160, NPROJ = 6144;
constexpr float EPS = 1e-6f;
constexpr int NWAVES = 8, NTHREADS = 512;

constexpr size_t MiB = 1u << 20;
constexpr size_t WS_CTL = 0, CTL_BYTES = 1 * MiB;
constexpr size_t WS_BETA = 1 * MiB;
constexpr size_t WS_G = WS_BETA + 512 * 1024;
constexpr size_t WS_RSTD1 = 2 * MiB, WS_RSTD2 = 2 * MiB + 65536;
constexpr size_t WS_WG = 3 * MiB;
constexpr size_t WS_RGSUM = WS_WG + 512 * 1024;
constexpr size_t WS_LIST = 4 * MiB;
constexpr size_t WS_WOUT = 12 * MiB;
constexpr size_t WS_W13 = 20 * MiB;
constexpr size_t WS_W2 = 148 * MiB;
constexpr size_t WS_WIN = 212 * MiB;
constexpr size_t WS_XN = 236 * MiB;
constexpr size_t WS_PROJ = 300 * MiB;
constexpr size_t PROJ_STRIDE = 32 * MiB;
constexpr size_t WS_ORAW = 236 * MiB  ;
constexpr size_t WS_MIX = 492 * MiB;
constexpr size_t WS_X1 = WS_PROJ + 2 * PROJ_STRIDE;
constexpr size_t WS_H2 = WS_WIN;
constexpr size_t WS_HB = 276 * MiB;
constexpr size_t WS_Y2 = WS_W13;
constexpr size_t WS_END = 556 * MiB;
constexpr size_t WS_RGA = WS_WIN;
constexpr size_t WS_RGB = 276 * MiB;

constexpr int CW_CNT = 64;
constexpr int CW_BAR = 4096;

DI unsigned f2bf(float f) { unsigned u = __float_as_uint(f); return (u + 0x7fffu + ((u >> 16) & 1u)) >> 16; }
DI unsigned pk2(float lo, float hi) { return f2bf(lo) | (f2bf(hi) << 16); }
DI float bf2f(unsigned b) { return __uint_as_float(b << 16); }
DI float bflo(unsigned w) { return __uint_as_float(w << 16); }
DI float bfhi(unsigned w) { return __uint_as_float(w & 0xffff0000u); }
DI float wave_sum(float v) {
#pragma unroll
    for (int o = 1; o < 64; o <<= 1) v += __shfl_xor(v, o);
    return v;
}
DI float sigmoidf_(float x) { return 1.f / (1.f + __expf(-x)); }
DI float siluf_(float x) { return x / (1.f + __expf(-x)); }
DI float softplusf_(float x) { return x > 20.f ? x : log1pf(expf(x)); }
DI float gelu_tanh(float x) { const float u = 0.7978845608028654f * (x + 0.044715f * x * x * x); return 0.5f * x * (1.f + tanhf(u)); }

namespace pg8 {
constexpr int BM = 256, BK = 64, HALF = 128, HTB = HALF * BK * 2, STAGE_BYTES = 8 * HTB;
DI int lds_byte(int r, int c) { const int st = (r >> 4) * 2 + (c >> 5), rr = r & 15, cc = c & 31, ob = rr * 64 + cc * 2; return st * 1024 + (ob ^ (((ob >> 9) & 1) << 5)); }
DI void stage_rc(int b, int& R, int& C) { const int st = b / 1024, sb = b % 1024, swz = sb ^ (((sb >> 9) & 1) << 5); R = (st >> 1) * 16 + swz / 64; C = (st & 1) * 32 + (swz % 64) / 2; }
DI int perm32(int rho) { const int n = rho >> 4, i = rho & 15; return 8 * (i >> 2) + 4 * n + (i & 3); }

struct Unit { const char* A; const char* B; int pm, pn; int e, nvalid; const void* rows; };

DI unsigned cvt_pk_bf16(float lo, float hi) { unsigned r; asm volatile("v_cvt_pk_bf16_f32 %0, %1, %2" : "=v"(r) : "v"(lo), "v"(hi)); return r; }

template <class Epi, class Sched, bool GATHER>
DI void gemm_phase(LAS unsigned char* lds, const int K, const Sched& S, const Epi& E) {
    const int tid = threadIdx.x, wid = __builtin_amdgcn_readfirstlane(tid >> 6), lane = tid & 63, wr = wid >> 2, wc = wid & 3, fr = lane & 15, fq = lane >> 4;
    const int nt = K / BK;
    unsigned voffA[2], voffB[2]; int RA[2], CA[2];
#pragma unroll
    for (int i = 0; i < 2; ++i) { int R, C; stage_rc(tid * 16 + i * 8192, R, C); const int Rb = Epi::PERM ? ((R & ~31) + perm32(R & 31)) : R;
        RA[i] = R; CA[i] = C; voffA[i] = (unsigned)(R * K + C) * 2u; voffB[i] = (unsigned)(Rb * K + C) * 2u; }
    const size_t kstep = (size_t)(BK * 2);
    const size_t hstep = (size_t)HALF * K * 2;
    const unsigned ldsw = (unsigned)wid * 1024u;
    const int aoff = lds_byte(wr * 64 + fr, fq * 8), boff = lds_byte(wc * 32 + fr, fq * 8);
#define PG8_SA(b, h) (((b) * 2 + (h)) * HTB)
#define PG8_SB(b, h) ((4 + (b) * 2 + (h)) * HTB)
#define PG8_STAGE(bufoff, gbase, voff) do { _Pragma("unroll") for (int _i = 0; _i < 2; ++_i) \
        __builtin_amdgcn_global_load_lds((const unsigned*)((const char*)(gbase) + (voff)[_i]), (LAS unsigned*)(lds + (bufoff) + ldsw + _i * 8192), 16, 0, 0); } while (0)
#define PG8_LDA(dst, b, h) do { _Pragma("unroll") for (int m = 0; m < 4; ++m) _Pragma("unroll") for (int k = 0; k < 2; ++k) dst[m][k] = *(const LAS bf16x8*)(lds + PG8_SA(b, h) + aoff + m * 2048 + k * 1024); } while (0)
#define PG8_LDB(dst, b, h) do { _Pragma("unroll") for (int n = 0; n < 2; ++n) _Pragma("unroll") for (int k = 0; k < 2; ++k) dst[n][k] = *(const LAS bf16x8*)(lds + PG8_SB(b, h) + boff + n * 2048 + k * 1024); } while (0)
#define PG8_MMA(ai, bj, At, Bt) do { __builtin_amdgcn_s_setprio(1); _Pragma("unroll") for (int m = 0; m < 4; ++m) _Pragma("unroll") for (int n = 0; n < 2; ++n) _Pragma("unroll") for (int k = 0; k < 2; ++k) \
        acc[ai][bj][m][n] = __builtin_amdgcn_mfma_f32_16x16x32_bf16(Bt[n][k], At[m][k], acc[ai][bj][m][n], 0, 0, 0); __builtin_amdgcn_s_setprio(0); } while (0)
#define PG8_WAIT_V(n) asm volatile("s_waitcnt vmcnt(" #n ")" ::: "memory")
#define PG8_WAIT_L(n) asm volatile("s_waitcnt lgkmcnt(" #n ")" ::: "memory")
#define PG8_BAR __builtin_amdgcn_s_barrier()
#define PG8_SCHED __builtin_amdgcn_sched_barrier(0)
    Unit cur, nxt; int ui = 0;
    if (!S.next(0, cur)) return;
    f32x4 acc[2][2][4][2];
#pragma unroll
    for (int a = 0; a < 2; ++a)
#pragma unroll
        for (int b = 0; b < 2; ++b)
#pragma unroll
            for (int m = 0; m < 4; ++m)
#pragma unroll
                for (int n = 0; n < 2; ++n) acc[a][b][m][n] = (f32x4){0.f, 0.f, 0.f, 0.f};
    bf16x8 At[4][2], B0[2][2], B1[2][2];
    unsigned gc0[2], gc1[2], gn0[2], gn1[2];
    if (GATHER) { S.row_offs(cur, RA, CA, K, gc0, gc1); asm volatile("" : "+v"(gc0[0]), "+v"(gc0[1]), "+v"(gc1[0]), "+v"(gc1[1])); }
    const char* cA = cur.A; const char* cB = cur.B;
    const size_t hA = GATHER ? 0 : hstep;
    PG8_STAGE(PG8_SB(0, 0), cB, voffB);
    if (GATHER) PG8_STAGE(PG8_SA(0, 0), cA, gc0); else PG8_STAGE(PG8_SA(0, 0), cA, voffA);
    PG8_STAGE(PG8_SB(0, 1), cB + hstep, voffB);
    if (GATHER) PG8_STAGE(PG8_SA(0, 1), cA, gc1); else PG8_STAGE(PG8_SA(0, 1), cA + hstep, voffA);
    if (wr == 1) PG8_BAR;
    PG8_WAIT_V(4); PG8_BAR;
    PG8_STAGE(PG8_SB(1, 0), cB + kstep, voffB);
    if (GATHER) PG8_STAGE(PG8_SA(1, 0), cA + kstep, gc0); else PG8_STAGE(PG8_SA(1, 0), cA + kstep, voffA);
    PG8_STAGE(PG8_SB(1, 1), cB + hstep + kstep, voffB);
    PG8_WAIT_V(6); PG8_BAR;
    for (;;) {
        const bool has_next = S.next(ui + 1, nxt);
        const char* nA = has_next ? nxt.A : cA; const char* nB = has_next ? nxt.B : cB;
        if (GATHER) {
            if (has_next) S.row_offs(nxt, RA, CA, K, gn0, gn1); else { gn0[0] = gc0[0]; gn0[1] = gc0[1]; gn1[0] = gc1[0]; gn1[1] = gc1[1]; }
            asm volatile("" : "+v"(gn0[0]), "+v"(gn0[1]), "+v"(gn1[0]), "+v"(gn1[1]));
        }
        for (int t = 0; t < nt; t += 2) {
            const bool last = (t == nt - 2);
            const char* a1 = cA + (size_t)(t + 1) * kstep;
            const char* a2 = last ? nA : cA + (size_t)(t + 2) * kstep; const char* b2 = last ? nB : cB + (size_t)(t + 2) * kstep;
            const char* a3 = a2 + kstep; const char* b3 = b2 + kstep;
            unsigned g20[2], g21[2];
            if (GATHER) { g20[0] = last ? gn0[0] : gc0[0]; g20[1] = last ? gn0[1] : gc0[1]; g21[0] = last ? gn1[0] : gc1[0]; g21[1] = last ? gn1[1] : gc1[1]; }
            PG8_LDB(B0, 0, 0); PG8_SCHED; PG8_LDA(At, 0, 0);
            if (GATHER) PG8_STAGE(PG8_SA(1, 1), a1, gc1); else PG8_STAGE(PG8_SA(1, 1), a1 + hstep, voffA);
            PG8_WAIT_L(8); PG8_BAR; PG8_WAIT_L(0); PG8_MMA(0, 0, At, B0); PG8_BAR; PG8_SCHED;
            PG8_LDB(B1, 0, 1); PG8_STAGE(PG8_SB(0, 0), b2, voffB);
            PG8_BAR; PG8_WAIT_L(0); PG8_MMA(0, 1, At, B1); PG8_BAR;
            PG8_LDA(At, 0, 1);
            if (GATHER) PG8_STAGE(PG8_SA(0, 0), a2, g20); else PG8_STAGE(PG8_SA(0, 0), a2, voffA);
            PG8_BAR; PG8_WAIT_L(0); PG8_MMA(1, 0, At, B0); PG8_BAR; PG8_SCHED;
            PG8_STAGE(PG8_SB(0, 1), b2 + hstep, voffB);
            PG8_WAIT_V(6); PG8_BAR; PG8_MMA(1, 1, At, B1); PG8_BAR;
            PG8_LDB(B0, 1, 0); PG8_SCHED; PG8_LDA(At, 1, 0);
            if (GATHER) PG8_STAGE(PG8_SA(0, 1), a2, g21); else PG8_STAGE(PG8_SA(0, 1), a2 + hstep, voffA);
            PG8_WAIT_L(8); PG8_BAR; PG8_WAIT_L(0); PG8_MMA(0, 0, At, B0); PG8_BAR; PG8_SCHED;
            PG8_LDB(B1, 1, 1); PG8_STAGE(PG8_SB(1, 0), b3, voffB);
            PG8_BAR; PG8_WAIT_L(0); PG8_MMA(0, 1, At, B1); PG8_BAR;
            PG8_LDA(At, 1, 1);
            if (GATHER) PG8_STAGE(PG8_SA(1, 0), a3, g20); else PG8_STAGE(PG8_SA(1, 0), a3, voffA);
            PG8_BAR; PG8_WAIT_L(0); PG8_MMA(1, 0, At, B0); PG8_BAR; PG8_SCHED;
            PG8_STAGE(PG8_SB(1, 1), b3 + hstep, voffB);
            PG8_WAIT_V(6); PG8_BAR; PG8_MMA(1, 1, At, B1); PG8_BAR;
        }
        { int tz = threadIdx.x; asm volatile("" : "+v"(tz));
          const int ewid = tz >> 6, elane = tz & 63; E(acc, cur, ewid >> 2, ewid & 3, elane & 15, elane >> 4); }
        if (!has_next) break;
#pragma unroll
        for (int a = 0; a < 2; ++a)
#pragma unroll
            for (int b = 0; b < 2; ++b)
#pragma unroll
                for (int m = 0; m < 4; ++m)
#pragma unroll
                    for (int n = 0; n < 2; ++n) acc[a][b][m][n] = (f32x4){0.f, 0.f, 0.f, 0.f};
        cur = nxt; cA = nA; cB = nB; ++ui;
        if (GATHER) { gc0[0] = gn0[0]; gc0[1] = gn0[1]; gc1[0] = gn1[0]; gc1[1] = gn1[1]; }
    }
    PG8_WAIT_V(0);
    if (wr == 0) PG8_BAR;
    PG8_BAR;
    (void)hA;
#undef PG8_SA
#undef PG8_SB
#undef PG8_STAGE
#undef PG8_LDA
#undef PG8_LDB
#undef PG8_MMA
#undef PG8_WAIT_V
#undef PG8_WAIT_L
#undef PG8_BAR
#undef PG8_SCHED
}
}

struct DenseSched {
    const char* A; const char* B; int K, nM, nN, nwg, G, c;
    DI void init(const void* A_, const void* B_, int Mrows, int N, int K_, int G_, int c_) { A = (const char*)A_; B = (const char*)B_; K = K_; nM = Mrows / 256; nN = N / 256; nwg = nM * nN; G = G_; c = c_; }
    DI bool next(int i, pg8::Unit& u) const {
        const int L = i * G + c; if (L >= nwg) return false;
        int wgid = L; { const int q = nwg / 8, r = nwg % 8, xcd = wgid % 8, off = wgid / 8; wgid = (xcd < r ? xcd * (q + 1) : r * (q + 1) + (xcd - r) * q) + off; }
        const int nig = 8 * nN, gid = wgid / nig, fm = gid * 8, gsz = (nM - fm) < 8 ? (nM - fm) : 8;
        u.pm = fm + ((wgid % nig) % gsz); u.pn = (wgid % nig) / gsz;
        u.A = A + (size_t)u.pm * 256 * K * 2; u.B = B + (size_t)u.pn * 256 * K * 2; u.e = 0; u.nvalid = 256; u.rows = nullptr; return true;
    }
    DI void row_offs(const pg8::Unit&, const int*, const int*, int, unsigned*, unsigned*) const {}
};
struct MoeSched {
    const char* A; const char* B; int K, NJ, BR, G, c, gather;
    const LAS int* tstart;
    const int* cnt; const char* list;
    DI bool next(int i, pg8::Unit& u) const {
        const int L = i * G + c; const int ttot = __builtin_amdgcn_readfirstlane(tstart[32]); if (L >= ttot * NJ) return false;
        const int tau = L / NJ, j = L % NJ;
        int e = 0;
        for (int q = 1; q < 32; ++q) e += (__builtin_amdgcn_readfirstlane(tstart[q]) <= tau) ? 1 : 0;
        const int lt = tau - __builtin_amdgcn_readfirstlane(tstart[e]);
        int nv = __builtin_amdgcn_readfirstlane(cnt[e]) - lt * 256; nv = nv > 256 ? 256 : nv;
        u.pm = tau; u.pn = j; u.e = e; u.nvalid = nv; u.rows = list + ((size_t)e * 16384 + (size_t)lt * 256) * 16;
        u.A = gather ? A : A + (size_t)tau * 256 * K * 2;
        u.B = B + ((size_t)e * BR + (size_t)j * 256) * K * 2; return true;
    }
    DI void row_offs(const pg8::Unit& u, const int* RA, const int* CA, int K_, unsigned* g0, unsigned* g1) const {
#pragma unroll
        for (int i = 0; i < 2; ++i) {
            const int r0 = RA[i], r1 = RA[i] + 128;
            int t0 = *(const int*)((const char*)u.rows + (size_t)r0 * 16), t1 = *(const int*)((const char*)u.rows + (size_t)r1 * 16);
            t0 = (r0 < u.nvalid) ? (t0 >> 1) : 0; t1 = (r1 < u.nvalid) ? (t1 >> 1) : 0;
            g0[i] = (unsigned)(t0 * K_ + CA[i]) * 2u; g1[i] = (unsigned)(t1 * K_ + CA[i]) * 2u;
        }
    }
};

struct EpiProj {
    static constexpr bool PERM = true;
    bf16_t* base; const float* rstd;
    DI void operator()(const f32x4 (&acc)[2][2][4][2], const pg8::Unit& u, int wr, int wc, int fr, int fq) const {
        const int colt = u.pn * 256; bf16_t* o = base + (size_t)(colt >> 10) * (PROJ_STRIDE / 2);
        const int col0 = (colt & 1023) + wc * 32 + 8 * fq, row0 = u.pm * 256 + wr * 64 + fr;
#pragma unroll
        for (int ai = 0; ai < 2; ++ai)
#pragma unroll
            for (int m = 0; m < 4; ++m) { bf16_t* rowp = o + (size_t)(row0 + ai * 128 + m * 16) * 1024 + col0; const float s = rstd[row0 + ai * 128 + m * 16];
#pragma unroll
                for (int bj = 0; bj < 2; ++bj) { const f32x4 v0 = acc[ai][bj][m][0] * s, v1 = acc[ai][bj][m][1] * s; u32x4 w;
                    w.x = pg8::cvt_pk_bf16(v0[0], v0[1]); w.y = pg8::cvt_pk_bf16(v0[2], v0[3]); w.z = pg8::cvt_pk_bf16(v1[0], v1[1]); w.w = pg8::cvt_pk_bf16(v1[2], v1[3]);
                    *(u32x4*)(rowp + bj * 128) = w; } }
    }
};
struct EpiX1 {
    static constexpr bool PERM = false;
    const float* x; float* x1;
    DI void operator()(const f32x4 (&acc)[2][2][4][2], const pg8::Unit& u, int wr, int wc, int fr, int fq) const {
        const int row0 = u.pm * 256 + wr * 64 + fr, col0 = u.pn * 256 + wc * 32 + 4 * fq;
#pragma unroll
        for (int ai = 0; ai < 2; ++ai)
#pragma unroll
            for (int m = 0; m < 4; ++m) { const size_t off = (size_t)(row0 + ai * 128 + m * 16) * D + col0;
#pragma unroll
                for (int bj = 0; bj < 2; ++bj)
#pragma unroll
                    for (int n = 0; n < 2; ++n) { const f32x4 xv = *(const f32x4*)(x + off + bj * 128 + n * 16); *(f32x4*)(x1 + off + bj * 128 + n * 16) = xv + acc[ai][bj][m][n]; } }
    }
};
struct EpiUp {
    static constexpr bool PERM = true;
    bf16_t* hb;
    DI void operator()(const f32x4 (&acc)[2][2][4][2], const pg8::Unit& u, int wr, int wc, int fr, int fq) const {
        const int col0 = u.pn * 128 + wc * 32 + 8 * fq;
#pragma unroll
        for (int ai = 0; ai < 2; ++ai)
#pragma unroll
            for (int m = 0; m < 4; ++m) { const int r = ai * 128 + wr * 64 + m * 16 + fr;
                const float s = *(const float*)((const char*)u.rows + (size_t)r * 16 + 4);
                float h[8];
#pragma unroll
                for (int n = 0; n < 2; ++n)
#pragma unroll
                    for (int e = 0; e < 4; ++e) { const float a1 = s * acc[ai][0][m][n][e], a3 = s * acc[ai][1][m][n][e]; h[n * 4 + e] = siluf_(a1) * a3; }
                u32x4 w; w.x = pg8::cvt_pk_bf16(h[0], h[1]); w.y = pg8::cvt_pk_bf16(h[2], h[3]); w.z = pg8::cvt_pk_bf16(h[4], h[5]); w.w = pg8::cvt_pk_bf16(h[6], h[7]);
                *(u32x4*)(hb + (size_t)(u.pm * 256 + r) * FF + col0) = w; }
    }
};
struct EpiDown {
    static constexpr bool PERM = true;
    bf16_t* y2;
    DI void operator()(const f32x4 (&acc)[2][2][4][2], const pg8::Unit& u, int wr, int wc, int fr, int fq) const {
        const int col0 = u.pn * 256 + wc * 32 + 8 * fq;
#pragma unroll
        for (int ai = 0; ai < 2; ++ai)
#pragma unroll
            for (int m = 0; m < 4; ++m) { const int r = ai * 128 + wr * 64 + m * 16 + fr;
                if (r < u.nvalid) {
                    const int t2 = *(const int*)((const char*)u.rows + (size_t)r * 16);
                    const float gt = *(const float*)((const char*)u.rows + (size_t)r * 16 + 8);
                    bf16_t* rowp = y2 + (size_t)t2 * D + col0;
#pragma unroll
                    for (int bj = 0; bj < 2; ++bj) { const f32x4 v0 = acc[ai][bj][m][0] * gt, v1 = acc[ai][bj][m][1] * gt; u32x4 w;
                        w.x = pg8::cvt_pk_bf16(v0[0], v0[1]); w.y = pg8::cvt_pk_bf16(v0[2], v0[3]); w.z = pg8::cvt_pk_bf16(v1[0], v1[1]); w.w = pg8::cvt_pk_bf16(v1[2], v1[3]);
                        *(u32x4*)(rowp + bj * 128) = w; } } }
    }
};

#define XB_TMO      128
#define XB_XCNT(j)  (256  + 64 * (j))
#define XB_XSUB(j)  (1280 + 64 * (j))
#define XB_XGEN(j)  (2304 + 64 * (j))
#define XB_TOP      3328
#define XB_TOPGEN   3392
#define XCD_BAR_WORDS 3456
#define XB_SPIN_CAP (1u << 22)
__device__ __forceinline__ unsigned xb_ld(unsigned* p)              { return __hip_atomic_load(p, __ATOMIC_RELAXED, __HIP_MEMORY_SCOPE_AGENT); }
__device__ __forceinline__ unsigned xb_add(unsigned* p, unsigned v) { return __hip_atomic_fetch_add(p, v, __ATOMIC_RELAXED, __HIP_MEMORY_SCOPE_AGENT); }
__device__ __forceinline__ unsigned xb_xcc_id() { return (unsigned)__builtin_amdgcn_s_getreg((3 << 11) | 20) & 0xFu; }
#define XB_SPIN(cond, bar) do { unsigned _sp = 0; while (cond) { __builtin_amdgcn_s_sleep(1); \
    if ((++_sp & 255u) == 0u) { if (xb_ld(&(bar)[XB_TMO])) break; if (_sp > XB_SPIN_CAP) { atomicAdd(&(bar)[XB_TMO], 1u); break; } } } } while (0)
struct XcdBarrier { unsigned* bar; unsigned x; volatile LAS unsigned* st; };
__device__ __forceinline__ XcdBarrier xcd_barrier_post(unsigned* bar, volatile LAS unsigned* st) {
    XcdBarrier b; b.bar = bar; b.x = xb_xcc_id(); b.st = st;
    if (threadIdx.x == 0) (void)xb_add(&bar[XB_XCNT(b.x)], 1u);
    return b;
}
__device__ __forceinline__ void xcd_barrier_complete(unsigned* bar, unsigned x, unsigned& nloc, unsigned& nx) {
    const unsigned G = gridDim.x * gridDim.y * gridDim.z;
    unsigned sum, cnt, mine, sp = 0u;
    for (;;) {
        sum = 0u; cnt = 0u; mine = 0u;
#pragma unroll
        for (unsigned j = 0; j < 16; ++j) { const unsigned c = xb_ld(&bar[XB_XCNT(j)]); sum += c; cnt += (c > 0u) ? 1u : 0u; mine = (j == x) ? c : mine; }
        if (sum == G) break;
        __builtin_amdgcn_s_sleep(1);
        if ((++sp & 255u) == 0u) { if (xb_ld(&bar[XB_TMO])) break; if (sp > XB_SPIN_CAP) { atomicAdd(&bar[XB_TMO], 1u); break; } }
    }
    nloc = mine > 0u ? mine : 1u; nx = cnt > 0u ? cnt : 1u;
}
__device__ __forceinline__ void xcd_barrier(const XcdBarrier& b) {
    asm volatile("s_waitcnt vmcnt(0)" ::: "memory");
    __syncthreads();
    if (threadIdx.x == 0) {
        unsigned* bar = b.bar;
        __builtin_amdgcn_s_waitcnt(0);
        unsigned nloc = b.st[0], nx = b.st[1];
        if (nloc == 0u) { xcd_barrier_complete(bar, b.x, nloc, nx); b.st[0] = nloc; b.st[1] = nx; }
        const unsigned old = xb_add(&bar[XB_XSUB(b.x)], 1u);
        const unsigned gen = old / nloc;
        if (old + 1u == (gen + 1u) * nloc) {
            __builtin_amdgcn_fence(__ATOMIC_RELEASE, "agent");
            asm volatile("s_waitcnt vmcnt(0)" ::: "memory");
            const unsigned og = xb_add(&bar[XB_TOP], 1u);
            const unsigned tg = og / nx;
            if (og + 1u == (tg + 1u) * nx) xb_add(&bar[XB_TOPGEN], 1u);
            else XB_SPIN(xb_ld(&bar[XB_TOPGEN]) == tg, bar);
            __builtin_amdgcn_fence(__ATOMIC_ACQUIRE, "agent");
            xb_add(&bar[XB_XGEN(b.x)], 1u);
            asm volatile("s_waitcnt vmcnt(0)" ::: "memory");
        } else {
            XB_SPIN(xb_ld(&bar[XB_XGEN(b.x)]) == gen, bar);
            __builtin_amdgcn_fence(__ATOMIC_ACQUIRE, "agent");
            asm volatile("s_waitcnt vmcnt(0)" ::: "memory");
        }
    }
    __syncthreads();
}

struct Args { const float* in[25]; float* out; unsigned char* ws; int ph_lo, ph_hi; };
enum { I_X = 0, I_NMW, I_WIN, I_GCW, I_ALOG, I_DTB, I_GNW, I_RCW, I_RCB, I_WRG, I_BRG, I_WIG, I_BIG, I_LAM, I_RNW, I_WOUT, I_NFW, I_RWG, I_RBG, I_RWE, I_RBE, I_W1, I_W3, I_W2, I_NFIN };

constexpr int LDS_STAGE = 131072, LDS_MISC = LDS_STAGE, LDS_TSTART = LDS_STAGE + 256, LDS_BYTES = 147456;

DI void transpose_item(const float* W, int ldw, bf16_t* WT, int ldt, LAS float* scr, int k0, int n0, int drow0, int lane) {
#pragma unroll 8
    for (int i = 0; i < 32; ++i) { const int kk = 2 * i + (lane >> 5); scr[kk * 33 + (lane & 31)] = W[(size_t)(k0 + kk) * ldw + n0 + (lane & 31)]; }
    asm volatile("s_waitcnt lgkmcnt(0)" ::: "memory");
    const int c = lane & 7;
#pragma unroll
    for (int j = 0; j < 4; ++j) { const int n = (lane >> 3) + 8 * j; const LAS float* s = scr + (8 * c) * 33 + n;
        u32x4 o; o.x = pk2(s[0 * 33], s[1 * 33]); o.y = pk2(s[2 * 33], s[3 * 33]); o.z = pk2(s[4 * 33], s[5 * 33]); o.w = pk2(s[6 * 33], s[7 * 33]);
        *(u32x4*)(WT + (size_t)(drow0 + n) * ldt + k0 + 8 * c) = o; }
    asm volatile("s_waitcnt lgkmcnt(0)" ::: "memory");
}

DI void p0_weights(const Args& a, LAS unsigned char* lds, int gw, int NGW, int wave, int lane) {
    LAS float* scr = (LAS float*)(lds + wave * 16384);
    unsigned char* ws = a.ws;
    constexpr int S0 = 32 * 128, S1 = 32 * 64, S2 = 32 * 64, S3 = 32 * 512, S4 = S3, S5 = 32 * 512, S6 = 64, S7 = 64;
    constexpr int NITEMS = S0 + S1 + S2 + S3 + S4 + S5 + S6 + S7;
    for (int it = gw; it < NITEMS; it += NGW) {
        int r = it;
        if (r < S0) { const int kb = r / 128, nb = r % 128; transpose_item(a.in[I_WIN], INCOLS, (bf16_t*)(ws + WS_WIN), D, scr, kb * 64, nb * 32, nb * 32, lane); continue; } r -= S0;
        if (r < S1) { const int kb = r / 64, nb = r % 64; transpose_item(a.in[I_WIN] + 4112, INCOLS, (bf16_t*)(ws + WS_WIN), D, scr, kb * 64, nb * 32, 4096 + nb * 32, lane); continue; } r -= S1;
        if (r < S2) { const int kb = r / 64, nb = r % 64; transpose_item(a.in[I_WOUT], D, (bf16_t*)(ws + WS_WOUT), D, scr, kb * 64, nb * 32, nb * 32, lane); continue; } r -= S2;
        if (r < S3 + S4) { const int w3 = r >= S3; if (w3) r -= S3; const int e = r / 512, q = r % 512, kb = q / 16, nb = q % 16, n0 = nb * 32;
            const int drow = (n0 >> 7) * 256 + (n0 & 127) + (w3 ? 128 : 0);
            transpose_item(a.in[w3 ? I_W3 : I_W1] + (size_t)e * D * FF, FF, (bf16_t*)(ws + WS_W13) + (size_t)e * 1024 * D, D, scr, kb * 64, n0, drow, lane); continue; } r -= S3 + S4;
        if (r < S5) { const int e = r / 512, q = r % 512, kb = q / 64, nb = q % 64;
            transpose_item(a.in[I_W2] + (size_t)e * FF * D, D, (bf16_t*)(ws + WS_W2) + (size_t)e * D * FF, FF, scr, kb * 64, nb * 32, nb * 32, lane); continue; } r -= S5;
        { const int ig = r >= S6; if (ig) r -= S6; const int n = r / 8, q = r % 8, kb = q / 4, nb = q % 4;
            transpose_item(a.in[ig ? I_WIG : I_WRG] + (size_t)n * 128 * 128, 128, (bf16_t*)(ws + WS_WG) + (size_t)n * 256 * 128, 128, scr, kb * 64, nb * 32, nb * 32 + (ig ? 128 : 0), lane); }
    }
}

typedef float f32x4v __attribute__((ext_vector_type(4)));
template <int MODE>
DI void row_pass16(const Args& a, const float* X, const float* wn, bf16_t* XNb, float* RSTD, int row0, int lane, LAS float* lg  ) {
    constexpr int NT = MODE == 0 ? 1 : 3;
    const int c = lane & 15, g = lane >> 4;
    f32x4 acc[NT];
#pragma unroll
    for (int t = 0; t < NT; ++t) acc[t] = (f32x4){0.f, 0.f, 0.f, 0.f};
    float ss = 0.f;
    const float* xr = X + (size_t)(row0 + c) * D + 8 * g;
    bf16_t* xo = XNb + (size_t)(row0 + c) * D + 8 * g;
    const float* wsm0 = MODE == 0 ? a.in[I_WIN] + 4096 + c : a.in[I_RWE] + c;
    const float* wgrp = a.in[I_RWG] + (c < 4 ? c : 0);
    for (int S = 0; S < 64; ++S) {
        f32x4 x0 = *(const f32x4*)(xr + 32 * S), x1 = *(const f32x4*)(xr + 32 * S + 4);
        const f32x4 w0 = *(const f32x4*)(wn + 32 * S + 8 * g), w1 = *(const f32x4*)(wn + 32 * S + 8 * g + 4);
        ss += (x0[0] * x0[0] + x0[1] * x0[1]) + (x0[2] * x0[2] + x0[3] * x0[3]) + (x1[0] * x1[0] + x1[1] * x1[1]) + (x1[2] * x1[2] + x1[3] * x1[3]);
        x0 = x0 * w0; x1 = x1 * w1;
        u32x4 o; o.x = pk2(x0[0], x0[1]); o.y = pk2(x0[2], x0[3]); o.z = pk2(x1[0], x1[1]); o.w = pk2(x1[2], x1[3]);
        *(u32x4*)(xo + 32 * S) = o;
#pragma unroll
        for (int e = 0; e < 8; ++e) {
            const int k = 32 * S + 8 * g + e; const float av = e < 4 ? x0[e & 3] : x1[e & 3];
            if (MODE == 0) { const float b = wsm0[(size_t)k * INCOLS]; acc[0] = __builtin_amdgcn_mfma_f32_16x16x4f32(av, b, acc[0], 0, 0, 0); }
            else { const float b0 = wsm0[(size_t)k * 32], b1 = wsm0[(size_t)k * 32 + 16]; float b2 = wgrp[(size_t)k * 4]; b2 = c < 4 ? b2 : 0.f;
                acc[0] = __builtin_amdgcn_mfma_f32_16x16x4f32(av, b0, acc[0], 0, 0, 0); acc[1] = __builtin_amdgcn_mfma_f32_16x16x4f32(av, b1, acc[1], 0, 0, 0);
                if (NT > 2) acc[NT - 1] = __builtin_amdgcn_mfma_f32_16x16x4f32(av, b2, acc[NT - 1], 0, 0, 0); }
        }
    }
    ss += __shfl_xor(ss, 16); ss += __shfl_xor(ss, 32);
    const float rstd = rsqrtf(ss * (1.f / D) + EPS);
    if (g == 0) RSTD[row0 + c] = rstd;
    float rs[4];
#pragma unroll
    for (int r = 0; r < 4; ++r) rs[r] = __shfl(rstd, 4 * g + r);
    if (MODE == 0) {
        const int hh = c & 7; const float al = __expf(a.in[I_ALOG][hh]), dtb = a.in[I_DTB][hh];
        float* BETA = (float*)(a.ws + WS_BETA); float* GG = (float*)(a.ws + WS_G);
#pragma unroll
        for (int r = 0; r < 4; ++r) { const float v = rs[r] * acc[0][r]; const int row = row0 + 4 * g + r;
            if (c < 8) BETA[(size_t)row * 8 + hh] = sigmoidf_(v); else GG[(size_t)row * 8 + hh] = -al * softplusf_(v + dtb); }
    } else {
        const float be0 = a.in[I_RBE][c], be1 = a.in[I_RBE][16 + c], bg = a.in[I_RBG][c < 4 ? c : 0];
#pragma unroll
        for (int r = 0; r < 4; ++r) { const int rr = 4 * g + r; lg[rr * 40 + c] = rs[r] * acc[0][r] + be0; lg[rr * 40 + 16 + c] = rs[r] * acc[1][r] + be1; if (c < 4) lg[rr * 40 + 32 + c] = rs[r] * acc[NT - 1][r] + bg; }
        asm volatile("s_waitcnt lgkmcnt(0)" ::: "memory");
        if (lane < 16) {
            const LAS float* L = lg + lane * 40; const int token = row0 + lane;
            float gm = L[32]; int gi = 0;
#pragma unroll
            for (int q = 1; q < 4; ++q) if (L[32 + q] > gm) { gm = L[32 + q]; gi = q; }
            float gs = 0.f;
#pragma unroll
            for (int q = 0; q < 4; ++q) gs += __expf(L[32 + q] - gm);
            const float gp = 1.f / gs;
            float ev[8];
#pragma unroll
            for (int q = 0; q < 8; ++q) ev[q] = L[gi * 8 + q];
            float m1 = ev[0]; int i1 = 0;
#pragma unroll
            for (int q = 1; q < 8; ++q) if (ev[q] > m1) { m1 = ev[q]; i1 = q; }
            float m2 = -3.0e38f; int i2 = 0;
#pragma unroll
            for (int q = 0; q < 8; ++q) if (q != i1 && ev[q] > m2) { m2 = ev[q]; i2 = q; }
            const float p2 = __expf(m2 - m1), den = 1.f / (1.f + p2);
            const float g1 = gp * den, g2 = gp * p2 * den;
            int* cnt = (int*)(a.ws + WS_CTL) + CW_CNT; const float myr = rstd;
            const int e1 = gi * 8 + i1, e2 = gi * 8 + i2;
            const int s1 = atomicAdd(cnt + e1, 1), s2 = atomicAdd(cnt + e2, 1);
            f32x4* l1 = (f32x4*)(a.ws + WS_LIST + ((size_t)e1 * 16384 + s1) * 16); f32x4* l2 = (f32x4*)(a.ws + WS_LIST + ((size_t)e2 * 16384 + s2) * 16);
            *l1 = (f32x4){__int_as_float(token * 2), myr, g1, 0.f}; *l2 = (f32x4){__int_as_float(token * 2 + 1), myr, g2, 0.f};
        }
        asm volatile("s_waitcnt lgkmcnt(0)" ::: "memory");
    }
}

DI void final_row(const float* x1, const bf16_t* y2, const float* w, float* out, int row, int lane) {
    const f32x4* xr = (const f32x4*)(x1 + (size_t)row * D) + lane;
    const u32x2* ya = (const u32x2*)(y2 + (size_t)(2 * row) * D) + lane; const u32x2* yb = (const u32x2*)(y2 + (size_t)(2 * row + 1) * D) + lane;
    f32x4 v[8]; float ss = 0.f;
#pragma unroll
    for (int j = 0; j < 8; ++j) { const f32x4 x = xr[64 * j]; const u32x2 p = ya[64 * j], q = yb[64 * j];
        v[j] = (f32x4){x[0] + bflo(p.x) + bflo(q.x), x[1] + bfhi(p.x) + bfhi(q.x), x[2] + bflo(p.y) + bflo(q.y), x[3] + bfhi(p.y) + bfhi(q.y)};
        ss += (v[j][0] * v[j][0] + v[j][1] * v[j][1]) + (v[j][2] * v[j][2] + v[j][3] * v[j][3]); }
    const float rstd = rsqrtf(wave_sum(ss) * (1.f / D) + EPS);
    f32x4* o = (f32x4*)(out + (size_t)row * D) + lane; const f32x4* wr = (const f32x4*)w + lane;
#pragma unroll
    for (int j = 0; j < 8; ++j) o[64 * j] = v[j] * rstd * wr[64 * j];
}

DI void naive_gdn(const Args& a, LAS unsigned char* lds, int bh, int tid) {
    LAS float (*sq)[128] = (LAS float (*)[128])(lds), (*sk)[128] = (LAS float (*)[128])(lds + 8192), (*sv)[128] = (LAS float (*)[128])(lds + 16384);
    LAS float (*red)[128] = (LAS float (*)[128])(lds + 24576), (*red2)[128] = (LAS float (*)[128])(lds + 26624);
    const int b = bh >> 3, h = bh & 7, lane = tid & 63, wave = tid >> 6;
    const bf16_t* P = (const bf16_t*)(a.ws + WS_PROJ);
    const float* gcw = a.in[I_GCW]; const float* BETA = (const float*)(a.ws + WS_BETA); const float* GG = (const float*)(a.ws + WS_G);
    float* ORAW = (float*)(a.ws + WS_ORAW);
    const int dvi = tid & 127, dkg = tid >> 7;
    float S[32];
#pragma unroll
    for (int j = 0; j < 32; ++j) S[j] = 0.f;
    for (int t0 = 0; t0 < T; t0 += 16) {
        for (int idx = tid; idx < 16 * 384; idx += 512) {
            const int tok = idx / 384, ch = idx % 384, which = ch >> 7, d = ch & 127, col = h * 128 + d, tt = t0 + tok;
            const bf16_t* src = P + (size_t)which * (PROJ_STRIDE / 2);
            float acc = 0.f;
#pragma unroll
            for (int j = 0; j < 4; ++j) { const int ts = tt - 3 + j; if (ts >= 0) acc += gcw[j * 3072 + which * 1024 + col] * bf2f(src[(size_t)(b * T + ts) * 1024 + col]); }
            const float v = siluf_(acc);
            if (which == 0) sq[tok][d] = v; else if (which == 1) sk[tok][d] = v; else sv[tok][d] = v;
        }
        __syncthreads();
        for (int q = wave; q < 32; q += 8) { const int tok = q >> 1; LAS float* p = (q & 1) ? sk[tok] : sq[tok];
            const float v0 = p[lane], v1 = p[lane + 64]; const float ss = wave_sum(v0 * v0 + v1 * v1);
            const float sc = rsqrtf(ss + EPS) * ((q & 1) ? 1.f : 0.08838834764831845f); p[lane] = v0 * sc; p[lane + 64] = v1 * sc; }
        __syncthreads();
        for (int tok = 0; tok < 16; ++tok) {
            const size_t row = (size_t)b * T + t0 + tok;
            const float eg = __expf(GG[row * 8 + h]), bt = BETA[row * 8 + h];
            float p = 0.f;
#pragma unroll
            for (int j = 0; j < 32; ++j) { S[j] *= eg; p += S[j] * sk[tok][dkg * 32 + j]; }
            red[dkg][dvi] = p;
            __syncthreads();
            const float kv = (red[0][dvi] + red[1][dvi]) + (red[2][dvi] + red[3][dvi]);
            const float delta = bt * (sv[tok][dvi] - kv);
            float po = 0.f;
#pragma unroll
            for (int j = 0; j < 32; ++j) { S[j] += sk[tok][dkg * 32 + j] * delta; po += S[j] * sq[tok][dkg * 32 + j]; }
            red2[dkg][dvi] = po;
            __syncthreads();
            if (dkg == 0) ORAW[row * 1024 + h * 128 + dvi] = (red2[0][dvi] + red2[1][dvi]) + (red2[2][dvi] + red2[3][dvi]);
        }
        __syncthreads();
    }
}
DI void naive_gdn_final(const Args& a, int gwv, int lane) {
    const int row = gwv >> 3, h = gwv & 7;
    const float* o = (const float*)(a.ws + WS_ORAW) + (size_t)row * 1024 + h * 128;
    const bf16_t* z = (const bf16_t*)(a.ws + WS_PROJ + 3 * PROJ_STRIDE) + (size_t)row * 1024 + h * 128;
    bf16_t* mix = (bf16_t*)(a.ws + WS_MIX) + (size_t)row * D + h * 128;
    const float v0 = o[lane], v1 = o[lane + 64]; const float rstd = rsqrtf(wave_sum(v0 * v0 + v1 * v1) * (1.f / 128.f) + EPS);
    mix[lane] = (bf16_t)f2bf(v0 * rstd * a.in[I_GNW][lane] * siluf_(bf2f(z[lane])));
    mix[lane + 64] = (bf16_t)f2bf(v1 * rstd * a.in[I_GNW][lane + 64] * siluf_(bf2f(z[lane + 64])));
}
DI void naive_rg_gates(const Args& a, LAS unsigned char* lds, int blk, int tid) {
    LAS float (*xc)[128] = (LAS float (*)[128])(lds);
    const int n = blk & 7, r0 = (blk >> 3) * 32;
    const bf16_t* RX = (const bf16_t*)(a.ws + WS_PROJ + 4 * PROJ_STRIDE);
    float* RA = (float*)(a.ws + WS_RGA); float* RB = (float*)(a.ws + WS_RGB);
    __syncthreads();
    for (int idx = tid; idx < 4096; idx += 512) { const int tok = idx >> 7, i = idx & 127, ch = n * 128 + i, row = r0 + tok, t = row % T;
        float acc = a.in[I_RCB][ch];
#pragma unroll
        for (int j = 0; j < 4; ++j) { const int ts = t - 3 + j; if (ts >= 0) acc += a.in[I_RCW][j * 1024 + ch] * bf2f(RX[(size_t)(row - 3 + j) * 1024 + ch]); }
        xc[tok][i] = acc; }
    __syncthreads();
    const int j = tid & 127, q4 = tid >> 7, ch = n * 128 + j;
    const float* Wr = a.in[I_WRG] + (size_t)n * 16384; const float* Wi = a.in[I_WIG] + (size_t)n * 16384;
    const float sp = softplusf_(-a.in[I_LAM][ch]);
    for (int tok = q4 * 8; tok < q4 * 8 + 8; ++tok) {
        float ar = a.in[I_BRG][ch], ai = a.in[I_BIG][ch];
        for (int i = 0; i < 128; ++i) { const float x = xc[tok][i]; ar += x * Wr[i * 128 + j]; ai += x * Wi[i * 128 + j]; }
        const float r = sigmoidf_(ar), ig = sigmoidf_(ai), la = -8.f * r * sp, av = __expf(la), mult = sqrtf(-expm1f(2.f * la));
        RA[(size_t)(r0 + tok) * 1024 + ch] = av; RB[(size_t)(r0 + tok) * 1024 + ch] = mult * ig * xc[tok][j]; }
}
DI void naive_rg_scan(const Args& a, int id) {
    const int b = id >> 10, ch = id & 1023;
    float* RA = (float*)(a.ws + WS_RGA); const float* RB = (const float*)(a.ws + WS_RGB);
    const bf16_t* RG = (const bf16_t*)(a.ws + WS_PROJ + 5 * PROJ_STRIDE);
    float h = 0.f;
    for (int t = 0; t < T; ++t) { const size_t o = (size_t)(b * T + t) * 1024 + ch; h = RA[o] * h + RB[o]; RA[o] = h * gelu_tanh(bf2f(RG[o])); }
}
DI void naive_rg_norm(const Args& a, int gwv, int lane) {
    const int row = gwv >> 3, n = gwv & 7;
    const float* y = (const float*)(a.ws + WS_RGA) + (size_t)row * 1024 + n * 128;
    bf16_t* mix = (bf16_t*)(a.ws + WS_MIX) + (size_t)row * D + 1024 + n * 128;
    const float v0 = y[lane], v1 = y[lane + 64]; const float rstd = rsqrtf(wave_sum(v0 * v0 + v1 * v1) * (1.f / 128.f) + EPS);
    mix[lane] = (bf16_t)f2bf(v0 * rstd * a.in[I_RNW][n * 128 + lane]); mix[lane + 64] = (bf16_t)f2bf(v1 * rstd * a.in[I_RNW][n * 128 + lane + 64]);
}

constexpr int NPHASES = 11;
__global__ void __launch_bounds__(NTHREADS, 2) fwd(Args a) {
    extern __shared__ __attribute__((aligned(16))) unsigned char lds_raw[];
    LAS unsigned char* lds = (LAS unsigned char*)lds_raw;
    const int tid = threadIdx.x, lane = tid & 63, wave = __builtin_amdgcn_readfirstlane(tid >> 6);
    const int G = gridDim.x, bx = blockIdx.x;
    const int vcu = (G % 8 == 0) ? (bx % 8) * (G / 8) + bx / 8 : bx;
    const int gw = vcu * NWAVES + wave, NGW = G * NWAVES;
    unsigned char* ws = a.ws;
    const int lo = a.ph_lo, hi = a.ph_hi;
    if (tid < 16) ((LAS unsigned*)(lds + LDS_MISC))[tid] = 0u;
    __syncthreads();
    XcdBarrier bar; bar.bar = (unsigned*)(ws + WS_CTL) + CW_BAR; bar.x = 0; bar.st = nullptr;
    if (hi - lo > 1) bar = xcd_barrier_post((unsigned*)(ws + WS_CTL) + CW_BAR, (volatile LAS unsigned*)(lds + LDS_MISC));
#define IN(k) (lo <= (k) && (k) < hi)
#define SEAM(k) do { if (IN(k) && IN((k) + 1)) xcd_barrier(bar); } while (0)
    if (IN(0)) {
        p0_weights(a, lds, gw, NGW, wave, lane);
        for (int task = gw; task < M / 16; task += NGW) row_pass16<0>(a, a.in[I_X], a.in[I_NMW], (bf16_t*)(ws + WS_XN), (float*)(ws + WS_RSTD1), task * 16, lane, nullptr);
    }
    SEAM(0);
    if (IN(1)) {
        DenseSched S; S.init(ws + WS_XN, ws + WS_WIN, M, NPROJ, D, G, bx);
        EpiProj E{(bf16_t*)(ws + WS_PROJ), (const float*)(ws + WS_RSTD1)};
        pg8::gemm_phase<EpiProj, DenseSched, false>(lds, D, S, E);
    }
    SEAM(1);
    if (IN(2)) { for (int u = bx; u < 16; u += G) naive_gdn(a, lds, u, tid); }
    SEAM(2);
    if (IN(3)) {
        for (int q = gw; q < M * 8; q += NGW) naive_gdn_final(a, q, lane);
        for (int blk = bx; blk < (M / 32) * 8; blk += G) naive_rg_gates(a, lds, blk, tid);
    }
    SEAM(3);
    if (IN(4)) { for (int id = bx * NTHREADS + tid; id < 2048; id += G * NTHREADS) naive_rg_scan(a, id); }
    SEAM(4);
    if (IN(5)) { for (int q = gw; q < M * 8; q += NGW) naive_rg_norm(a, q, lane); }
    SEAM(5);
    if (IN(6)) {
        DenseSched S; S.init(ws + WS_MIX, ws + WS_WOUT, M, D, D, G, bx);
        EpiX1 E{a.in[I_X], (float*)(ws + WS_X1)};
        pg8::gemm_phase<EpiX1, DenseSched, false>(lds, D, S, E);
    }
    SEAM(6);
    if (IN(7)) {
        LAS float* lg = (LAS float*)(lds + wave * 4096);
        for (int task = gw; task < M / 16; task += NGW) row_pass16<1>(a, (const float*)(ws + WS_X1), a.in[I_NFW], (bf16_t*)(ws + WS_H2), (float*)(ws + WS_RSTD2), task * 16, lane, lg);
    }
    SEAM(7);
    if (IN(8) || IN(9)) {
        LAS int* tstart = (LAS int*)(lds + LDS_TSTART);
        const int* cnt = (const int*)(ws + WS_CTL) + CW_CNT;
        if (wave == 0) { const int cn = lane < 32 ? cnt[lane] : 0; const int ntl = (cn + 255) >> 8; int incl = ntl;
#pragma unroll
            for (int o = 1; o < 32; o <<= 1) { const int v = __shfl_up(incl, o); if (lane >= o) incl += v; }
            if (lane < 32) tstart[lane] = incl - ntl; if (lane == 31) tstart[32] = incl; }
        __syncthreads();
        if (IN(8)) {
            MoeSched S{(const char*)(ws + WS_H2), (const char*)(ws + WS_W13), D, 4, 1024, G, bx, 1, tstart, cnt, (const char*)(ws + WS_LIST)};
            EpiUp E{(bf16_t*)(ws + WS_HB)};
            pg8::gemm_phase<EpiUp, MoeSched, true>(lds, D, S, E);
        }
        SEAM(8);
        if (IN(9)) {
            MoeSched S{(const char*)(ws + WS_HB), (const char*)(ws + WS_W2), FF, 8, 2048, G, bx, 0, tstart, cnt, (const char*)(ws + WS_LIST)};
            EpiDown E{(bf16_t*)(ws + WS_Y2)};
            pg8::gemm_phase<EpiDown, MoeSched, false>(lds, FF, S, E);
        }
    }
    SEAM(9);
    if (IN(10)) {
        for (int row = gw; row < M; row += NGW) final_row((const float*)(ws + WS_X1), (const bf16_t*)(ws + WS_Y2), a.in[I_NFIN], a.out, row, lane);
    }
#undef IN
#undef SEAM
}

#ifndef N_LAUNCHES
#define N_LAUNCHES 1
#endif
extern "C" void kernel_launch(void* const* d_in, const int* in_sizes, int n_in, void* d_out, int out_size, void* d_ws, size_t ws_size, hipStream_t stream) {
    static int grid = 0;
    if (grid == 0) {
        if (n_in != 25 || ws_size < WS_END) { fprintf(stderr, "kernel_launch: unexpected n_in %d or ws_size %zu (< %zu)\n", n_in, ws_size, (size_t)WS_END); grid = -1; return; }
        int dev = 0, cus = 0; (void)hipGetDevice(&dev); (void)hipDeviceGetAttribute(&cus, hipDeviceAttributeMultiprocessorCount, dev);
        if (hipFuncSetAttribute((const void*)fwd, hipFuncAttributeMaxDynamicSharedMemorySize, LDS_BYTES) != hipSuccess) { fprintf(stderr, "kernel_launch: hipFuncSetAttribute failed\n"); grid = -1; return; }
        int per_cu = 0; (void)hipOccupancyMaxActiveBlocksPerMultiprocessor(&per_cu, (const void*)fwd, NTHREADS, LDS_BYTES); (void)hipGetLastError();
        if (per_cu < 1) fprintf(stderr, "kernel_launch: occupancy query reports %d blocks per CU\n", per_cu);
        grid = cus > 0 ? cus : 256;
    }
    if (grid < 0) return;
    (void)hipMemsetAsync((char*)d_ws + WS_CTL, 0, CTL_BYTES, stream);
    Args a{};
    for (int i = 0; i < 25; ++i) a.in[i] = (const float*)d_in[i];
    a.out = (float*)d_out; a.ws = (unsigned char*)d_ws;
    if (N_LAUNCHES == 1) { a.ph_lo = 0; a.ph_hi = NPHASES; hipLaunchKernelGGL(fwd, dim3(grid), dim3(NTHREADS), LDS_BYTES, stream, a); }
    else for (int p = 0; p < NPHASES; ++p) { a.ph_lo = p; a.ph_hi = p + 1; hipLaunchKernelGGL(fwd, dim3(grid), dim3(NTHREADS), LDS_BYTES, stream, a); }
}
```

```cpp
#include <hip/hip_runtime.h>
#include <cstdio>
#include <cstdint>

#define DI __device__ __forceinline__
#define LAS __attribute__((address_space(3)))
typedef unsigned short bf16_t;
typedef short bf16x8 __attribute__((ext_vector_type(8)));
typedef float f32x4 __attribute__((ext_vector_type(4)));
typedef float f32x2 __attribute__((ext_vector_type(2)));
typedef unsigned u32x4 __attribute__((ext_vector_type(4)));
typedef unsigned u32x2 __attribute__((ext_vector_type(2)));

constexpr int NB = 2, T = 8192, M = NB * T, D = 2048;
constexpr int NH = 8, HD = 128, GW = 1024, RW = 1024, RGB = 8, RBD = 128;
constexpr int NE = 32, NG = 4, EPG = 8, FF = 512;
constexpr int INCOLS = 6160, NPROJ = 6144;
constexpr float EPS = 1e-6f;
constexpr int NWAVES = 8, NTHREADS = 512;

constexpr size_t MiB = 1u << 20;
constexpr size_t WS_CTL = 0, CTL_BYTES = 1 * MiB;
constexpr size_t WS_BETA = 1 * MiB;
constexpr size_t WS_G = WS_BETA + 512 * 1024;
constexpr size_t WS_RSTD1 = 2 * MiB, WS_RSTD2 = 2 * MiB + 65536;
constexpr size_t WS_WG = 3 * MiB;
constexpr size_t WS_RGSUM = WS_WG + 512 * 1024;
constexpr size_t WS_LIST = 4 * MiB;
constexpr size_t WS_WOUT = 12 * MiB;
constexpr size_t WS_W13 = 20 * MiB;
constexpr size_t WS_W2 = 148 * MiB;
constexpr size_t WS_WIN = 212 * MiB;
constexpr size_t WS_XN = 236 * MiB;
constexpr size_t WS_PROJ = 300 * MiB;
constexpr size_t PROJ_STRIDE = 32 * MiB;
constexpr size_t WS_ORAW = 300 * MiB  ;
constexpr size_t WS_MIX = 492 * MiB;
constexpr size_t WS_X1 = WS_PROJ + 2 * PROJ_STRIDE;
constexpr size_t WS_H2 = WS_WIN;
constexpr size_t WS_HB = 276 * MiB;
constexpr size_t WS_Y2 = WS_W13;
constexpr size_t WS_END = 556 * MiB;
constexpr size_t WS_QG = 20 * MiB, WS_KDT = 52 * MiB, WS_U = 84 * MiB, WS_WN = 116 * MiB, WS_AT = 148 * MiB, WS_GAM = 164 * MiB;
constexpr size_t WS_RGA = WS_WIN;
constexpr size_t WS_RGB = 276 * MiB;

constexpr int CW_CNT = 64;
constexpr int CW_BAR = 4096;

DI unsigned f2bf(float f) { unsigned u = __float_as_uint(f); return (u + 0x7fffu + ((u >> 16) & 1u)) >> 16; }
DI unsigned pk2(float lo, float hi) { return f2bf(lo) | (f2bf(hi) << 16); }
DI float bf2f(unsigned b) { return __uint_as_float(b << 16); }
DI float bflo(unsigned w) { return __uint_as_float(w << 16); }
DI float bfhi(unsigned w) { return __uint_as_float(w & 0xffff0000u); }
DI float wave_sum(float v) {
#pragma unroll
    for (int o = 1; o < 64; o <<= 1) v += __shfl_xor(v, o);
    return v;
}
DI float sigmoidf_(float x) { return 1.f / (1.f + __expf(-x)); }
DI float siluf_(float x) { return x / (1.f + __expf(-x)); }
DI float softplusf_(float x) { return x > 20.f ? x : log1pf(expf(x)); }
DI float gelu_tanh(float x) { const float u = 0.7978845608028654f * (x + 0.044715f * x * x * x); return 0.5f * x * (1.f + tanhf(u)); }

namespace pg8 {
constexpr int BM = 256, BK = 64, HALF = 128, HTB = HALF * BK * 2, STAGE_BYTES = 8 * HTB;
DI int lds_byte(int r, int c) { const int st = (r >> 4) * 2 + (c >> 5), rr = r & 15, cc = c & 31, ob = rr * 64 + cc * 2; return st * 1024 + (ob ^ (((ob >> 9) & 1) << 5)); }
DI void stage_rc(int b, int& R, int& C) { const int st = b / 1024, sb = b % 1024, swz = sb ^ (((sb >> 9) & 1) << 5); R = (st >> 1) * 16 + swz / 64; C = (st & 1) * 32 + (swz % 64) / 2; }
DI int perm32(int rho) { const int n = rho >> 4, i = rho & 15; return 8 * (i >> 2) + 4 * n + (i & 3); }

struct Unit { const char* A; const char* B; int pm, pn; int e, nvalid; const void* rows; };

DI unsigned cvt_pk_bf16(float lo, float hi) { unsigned r; asm volatile("v_cvt_pk_bf16_f32 %0, %1, %2" : "=v"(r) : "v"(lo), "v"(hi)); return r; }

template <class Epi, class Sched, bool GATHER>
DI void gemm_phase(LAS unsigned char* lds, const int K, const Sched& S, const Epi& E) {
    const int tid = threadIdx.x, wid = __builtin_amdgcn_readfirstlane(tid >> 6), lane = tid & 63, wr = wid >> 2, wc = wid & 3, fr = lane & 15, fq = lane >> 4;
    const int nt = K / BK;
    unsigned voffA[2], voffB[2]; int RA[2], CA[2];
#pragma unroll
    for (int i = 0; i < 2; ++i) { int R, C; stage_rc(tid * 16 + i * 8192, R, C); const int Rb = Epi::PERM ? ((R & ~31) + perm32(R & 31)) : R;
        RA[i] = R; CA[i] = C; voffA[i] = (unsigned)(R * K + C) * 2u; voffB[i] = (unsigned)(Rb * K + C) * 2u; }
    const size_t kstep = (size_t)(BK * 2);
    const size_t hstep = (size_t)HALF * K * 2;
    const unsigned ldsw = (unsigned)wid * 1024u;
    const int aoff = lds_byte(wr * 64 + fr, fq * 8), boff = lds_byte(wc * 32 + fr, fq * 8);
#define PG8_SA(b, h) (((b) * 2 + (h)) * HTB)
#define PG8_SB(b, h) ((4 + (b) * 2 + (h)) * HTB)
#define PG8_STAGE(bufoff, gbase, voff) do { _Pragma("unroll") for (int _i = 0; _i < 2; ++_i) \
        __builtin_amdgcn_global_load_lds((const unsigned*)((const char*)(gbase) + (voff)[_i]), (LAS unsigned*)(lds + (bufoff) + ldsw + _i * 8192), 16, 0, 0); } while (0)
#define PG8_LDA(dst, b, h) do { _Pragma("unroll") for (int m = 0; m < 4; ++m) _Pragma("unroll") for (int k = 0; k < 2; ++k) dst[m][k] = *(const LAS bf16x8*)(lds + PG8_SA(b, h) + aoff + m * 2048 + k * 1024); } while (0)
#define PG8_LDB(dst, b, h) do { _Pragma("unroll") for (int n = 0; n < 2; ++n) _Pragma("unroll") for (int k = 0; k < 2; ++k) dst[n][k] = *(const LAS bf16x8*)(lds + PG8_SB(b, h) + boff + n * 2048 + k * 1024); } while (0)
#define PG8_MMA(ai, bj, At, Bt) do { __builtin_amdgcn_s_setprio(1); _Pragma("unroll") for (int m = 0; m < 4; ++m) _Pragma("unroll") for (int n = 0; n < 2; ++n) _Pragma("unroll") for (int k = 0; k < 2; ++k) \
        acc[ai][bj][m][n] = __builtin_amdgcn_mfma_f32_16x16x32_bf16(Bt[n][k], At[m][k], acc[ai][bj][m][n], 0, 0, 0); __builtin_amdgcn_s_setprio(0); } while (0)
#define PG8_WAIT_V(n) asm volatile("s_waitcnt vmcnt(" #n ")" ::: "memory")
#define PG8_WAIT_L(n) asm volatile("s_waitcnt lgkmcnt(" #n ")" ::: "memory")
#define PG8_BAR __builtin_amdgcn_s_barrier()
#define PG8_SCHED __builtin_amdgcn_sched_barrier(0)
    Unit cur, nxt; int ui = 0;
    if (!S.next(0, cur)) return;
    f32x4 acc[2][2][4][2];
#pragma unroll
    for (int a = 0; a < 2; ++a)
#pragma unroll
        for (int b = 0; b < 2; ++b)
#pragma unroll
            for (int m = 0; m < 4; ++m)
#pragma unroll
                for (int n = 0; n < 2; ++n) acc[a][b][m][n] = (f32x4){0.f, 0.f, 0.f, 0.f};
    bf16x8 At[4][2], B0[2][2], B1[2][2];
    unsigned gc0[2], gc1[2], gn0[2], gn1[2];
    if (GATHER) { S.row_offs(cur, RA, CA, K, gc0, gc1); asm volatile("" : "+v"(gc0[0]), "+v"(gc0[1]), "+v"(gc1[0]), "+v"(gc1[1])); }
    const char* cA = cur.A; const char* cB = cur.B;
    const size_t hA = GATHER ? 0 : hstep;
    PG8_STAGE(PG8_SB(0, 0), cB, voffB);
    if (GATHER) PG8_STAGE(PG8_SA(0, 0), cA, gc0); else PG8_STAGE(PG8_SA(0, 0), cA, voffA);
    PG8_STAGE(PG8_SB(0, 1), cB + hstep, voffB);
    if (GATHER) PG8_STAGE(PG8_SA(0, 1), cA, gc1); else PG8_STAGE(PG8_SA(0, 1), cA + hstep, voffA);
    if (wr == 1) PG8_BAR;
    PG8_WAIT_V(4); PG8_BAR;
    PG8_STAGE(PG8_SB(1, 0), cB + kstep, voffB);
    if (GATHER) PG8_STAGE(PG8_SA(1, 0), cA + kstep, gc0); else PG8_STAGE(PG8_SA(1, 0), cA + kstep, voffA);
    PG8_STAGE(PG8_SB(1, 1), cB + hstep + kstep, voffB);
    PG8_WAIT_V(6); PG8_BAR;
    for (;;) {
        const bool has_next = S.next(ui + 1, nxt);
        const char* nA = has_next ? nxt.A : cA; const char* nB = has_next ? nxt.B : cB;
        if (GATHER) {
            if (has_next) S.row_offs(nxt, RA, CA, K, gn0, gn1); else { gn0[0] = gc0[0]; gn0[1] = gc0[1]; gn1[0] = gc1[0]; gn1[1] = gc1[1]; }
            asm volatile("" : "+v"(gn0[0]), "+v"(gn0[1]), "+v"(gn1[0]), "+v"(gn1[1]));
        }
        for (int t = 0; t < nt; t += 2) {
            const bool last = (t == nt - 2);
            const char* a1 = cA + (size_t)(t + 1) * kstep;
            const char* a2 = last ? nA : cA + (size_t)(t + 2) * kstep; const char* b2 = last ? nB : cB + (size_t)(t + 2) * kstep;
            const char* a3 = a2 + kstep; const char* b3 = b2 + kstep;
            unsigned g20[2], g21[2];
            if (GATHER) { g20[0] = last ? gn0[0] : gc0[0]; g20[1] = last ? gn0[1] : gc0[1]; g21[0] = last ? gn1[0] : gc1[0]; g21[1] = last ? gn1[1] : gc1[1]; }
            PG8_LDB(B0, 0, 0); PG8_SCHED; PG8_LDA(At, 0, 0);
            if (GATHER) PG8_STAGE(PG8_SA(1, 1), a1, gc1); else PG8_STAGE(PG8_SA(1, 1), a1 + hstep, voffA);
            PG8_WAIT_L(8); PG8_BAR; PG8_WAIT_L(0); PG8_MMA(0, 0, At, B0); PG8_BAR; PG8_SCHED;
            PG8_LDB(B1, 0, 1); PG8_STAGE(PG8_SB(0, 0), b2, voffB);
            PG8_BAR; PG8_WAIT_L(0); PG8_MMA(0, 1, At, B1); PG8_BAR;
            PG8_LDA(At, 0, 1);
            if (GATHER) PG8_STAGE(PG8_SA(0, 0), a2, g20); else PG8_STAGE(PG8_SA(0, 0), a2, voffA);
            PG8_BAR; PG8_WAIT_L(0); PG8_MMA(1, 0, At, B0); PG8_BAR; PG8_SCHED;
            PG8_STAGE(PG8_SB(0, 1), b2 + hstep, voffB);
            PG8_WAIT_V(6); PG8_BAR; PG8_MMA(1, 1, At, B1); PG8_BAR;
            PG8_LDB(B0, 1, 0); PG8_SCHED; PG8_LDA(At, 1, 0);
            if (GATHER) PG8_STAGE(PG8_SA(0, 1), a2, g21); else PG8_STAGE(PG8_SA(0, 1), a2 + hstep, voffA);
            PG8_WAIT_L(8); PG8_BAR; PG8_WAIT_L(0); PG8_MMA(0, 0, At, B0); PG8_BAR; PG8_SCHED;
            PG8_LDB(B1, 1, 1); PG8_STAGE(PG8_SB(1, 0), b3, voffB);
            PG8_BAR; PG8_WAIT_L(0); PG8_MMA(0, 1, At, B1); PG8_BAR;
            PG8_LDA(At, 1, 1);
            if (GATHER) PG8_STAGE(PG8_SA(1, 0), a3, g20); else PG8_STAGE(PG8_SA(1, 0), a3, voffA);
            PG8_BAR; PG8_WAIT_L(0); PG8_MMA(1, 0, At, B0); PG8_BAR; PG8_SCHED;
            PG8_STAGE(PG8_SB(1, 1), b3 + hstep, voffB);
            PG8_WAIT_V(6); PG8_BAR; PG8_MMA(1, 1, At, B1); PG8_BAR;
        }
        { int tz = threadIdx.x; asm volatile("" : "+v"(tz));
          const int ewid = tz >> 6, elane = tz & 63; E(acc, cur, ewid >> 2, ewid & 3, elane & 15, elane >> 4); }
        if (!has_next) break;
#pragma unroll
        for (int a = 0; a < 2; ++a)
#pragma unroll
            for (int b = 0; b < 2; ++b)
#pragma unroll
                for (int m = 0; m < 4; ++m)
#pragma unroll
                    for (int n = 0; n < 2; ++n) acc[a][b][m][n] = (f32x4){0.f, 0.f, 0.f, 0.f};
        cur = nxt; cA = nA; cB = nB; ++ui;
        if (GATHER) { gc0[0] = gn0[0]; gc0[1] = gn0[1]; gc1[0] = gn1[0]; gc1[1] = gn1[1]; }
    }
    PG8_WAIT_V(0);
    if (wr == 0) PG8_BAR;
    PG8_BAR;
    (void)hA;
#undef PG8_SA
#undef PG8_SB
#undef PG8_STAGE
#undef PG8_LDA
#undef PG8_LDB
#undef PG8_MMA
#undef PG8_WAIT_V
#undef PG8_WAIT_L
#undef PG8_BAR
#undef PG8_SCHED
}
}

struct DenseSched {
    const char* A; const char* B; int K, nM, nN, nwg, G, c;
    DI void init(const void* A_, const void* B_, int Mrows, int N, int K_, int G_, int c_) { A = (const char*)A_; B = (const char*)B_; K = K_; nM = Mrows / 256; nN = N / 256; nwg = nM * nN; G = G_; c = c_; }
    DI bool next(int i, pg8::Unit& u) const {
        const int L = i * G + c; if (L >= nwg) return false;
        int wgid = L; { const int q = nwg / 8, r = nwg % 8, xcd = wgid % 8, off = wgid / 8; wgid = (xcd < r ? xcd * (q + 1) : r * (q + 1) + (xcd - r) * q) + off; }
        const int nig = 8 * nN, gid = wgid / nig, fm = gid * 8, gsz = (nM - fm) < 8 ? (nM - fm) : 8;
        u.pm = fm + ((wgid % nig) % gsz); u.pn = (wgid % nig) / gsz;
        u.A = A + (size_t)u.pm * 256 * K * 2; u.B = B + (size_t)u.pn * 256 * K * 2; u.e = 0; u.nvalid = 256; u.rows = nullptr; return true;
    }
    DI void row_offs(const pg8::Unit&, const int*, const int*, int, unsigned*, unsigned*) const {}
};
struct MoeSched {
    const char* A; const char* B; int K, NJ, BR, G, c, gather;
    const LAS int* tstart;
    const int* cnt; const char* list;
    DI bool next(int i, pg8::Unit& u) const {
        const int L = i * G + c; const int ttot = __builtin_amdgcn_readfirstlane(tstart[32]); if (L >= ttot * NJ) return false;
        const int tau = L / NJ, j = L % NJ;
        int e = 0;
        for (int q = 1; q < 32; ++q) e += (__builtin_amdgcn_readfirstlane(tstart[q]) <= tau) ? 1 : 0;
        e = __builtin_amdgcn_readfirstlane(e);
        const int lt = tau - __builtin_amdgcn_readfirstlane(tstart[e]);
        int nv = __builtin_amdgcn_readfirstlane(cnt[e]) - lt * 256; nv = nv > 256 ? 256 : nv;
        u.pm = tau; u.pn = j; u.e = e; u.nvalid = nv;
        const size_t roff = ((size_t)e * 16384 + (size_t)lt * 256) * 16, aoffb = gather ? 0 : (size_t)tau * 256 * K * 2, boffb = ((size_t)e * BR + (size_t)j * 256) * K * 2;
        u.rows = list + (((size_t)__builtin_amdgcn_readfirstlane((int)(roff >> 32)) << 32) | (unsigned)__builtin_amdgcn_readfirstlane((int)roff));
        u.A = A + (((size_t)__builtin_amdgcn_readfirstlane((int)(aoffb >> 32)) << 32) | (unsigned)__builtin_amdgcn_readfirstlane((int)aoffb));
        u.B = B + (((size_t)__builtin_amdgcn_readfirstlane((int)(boffb >> 32)) << 32) | (unsigned)__builtin_amdgcn_readfirstlane((int)boffb));
        return true;
    }
    DI void row_offs(const pg8::Unit& u, const int* RA, const int* CA, int K_, unsigned* g0, unsigned* g1) const {
#pragma unroll
        for (int i = 0; i < 2; ++i) {
            const int r0 = RA[i], r1 = RA[i] + 128;
            int t0 = *(const int*)((const char*)u.rows + (size_t)r0 * 16), t1 = *(const int*)((const char*)u.rows + (size_t)r1 * 16);
            t0 = (r0 < u.nvalid) ? (t0 >> 1) : 0; t1 = (r1 < u.nvalid) ? (t1 >> 1) : 0;
            g0[i] = (unsigned)(t0 * K_ + CA[i]) * 2u; g1[i] = (unsigned)(t1 * K_ + CA[i]) * 2u;
        }
    }
};

struct EpiProj {
    static constexpr bool PERM = true;
    bf16_t* base; const float* rstd;
    DI void operator()(const f32x4 (&acc)[2][2][4][2], const pg8::Unit& u, int wr, int wc, int fr, int fq) const {
        const int colt = u.pn * 256; bf16_t* o = base + (size_t)(colt >> 10) * (PROJ_STRIDE / 2);
        const int col0 = (colt & 1023) + wc * 32 + 8 * fq, row0 = u.pm * 256 + wr * 64 + fr;
#pragma unroll
        for (int ai = 0; ai < 2; ++ai)
#pragma unroll
            for (int m = 0; m < 4; ++m) { bf16_t* rowp = o + (size_t)(row0 + ai * 128 + m * 16) * 1024 + col0; const float s = rstd[row0 + ai * 128 + m * 16];
#pragma unroll
                for (int bj = 0; bj < 2; ++bj) { const f32x4 v0 = acc[ai][bj][m][0] * s, v1 = acc[ai][bj][m][1] * s; u32x4 w;
                    w.x = pg8::cvt_pk_bf16(v0[0], v0[1]); w.y = pg8::cvt_pk_bf16(v0[2], v0[3]); w.z = pg8::cvt_pk_bf16(v1[0], v1[1]); w.w = pg8::cvt_pk_bf16(v1[2], v1[3]);
                    *(u32x4*)(rowp + bj * 128) = w; } }
    }
};
struct EpiX1 {
    static constexpr bool PERM = false;
    const float* x; float* x1;
    DI void operator()(const f32x4 (&acc)[2][2][4][2], const pg8::Unit& u, int wr, int wc, int fr, int fq) const {
        const int row0 = u.pm * 256 + wr * 64 + fr, col0 = u.pn * 256 + wc * 32 + 4 * fq;
#pragma unroll
        for (int ai = 0; ai < 2; ++ai)
#pragma unroll
            for (int m = 0; m < 4; ++m) { const size_t off = (size_t)(row0 + ai * 128 + m * 16) * D + col0;
#pragma unroll
                for (int bj = 0; bj < 2; ++bj)
#pragma unroll
                    for (int n = 0; n < 2; ++n) { const f32x4 xv = *(const f32x4*)(x + off + bj * 128 + n * 16); *(f32x4*)(x1 + off + bj * 128 + n * 16) = xv + acc[ai][bj][m][n]; } }
    }
};
struct EpiUp {
    static constexpr bool PERM = true;
    bf16_t* hb;
    DI void operator()(const f32x4 (&acc)[2][2][4][2], const pg8::Unit& u, int wr, int wc, int fr, int fq) const {
        const int col0 = u.pn * 128 + wc * 32 + 8 * fq;
#pragma unroll
        for (int ai = 0; ai < 2; ++ai)
#pragma unroll
            for (int m = 0; m < 4; ++m) { const int r = ai * 128 + wr * 64 + m * 16 + fr;
                const float s = *(const float*)((const char*)u.rows + (size_t)r * 16 + 4);
                float h[8];
#pragma unroll
                for (int n = 0; n < 2; ++n)
#pragma unroll
                    for (int e = 0; e < 4; ++e) { const float a1 = s * acc[ai][0][m][n][e], a3 = s * acc[ai][1][m][n][e]; h[n * 4 + e] = siluf_(a1) * a3; }
                u32x4 w; w.x = pg8::cvt_pk_bf16(h[0], h[1]); w.y = pg8::cvt_pk_bf16(h[2], h[3]); w.z = pg8::cvt_pk_bf16(h[4], h[5]); w.w = pg8::cvt_pk_bf16(h[6], h[7]);
                *(u32x4*)(hb + (size_t)(u.pm * 256 + r) * FF + col0) = w; }
    }
};
struct EpiDown {
    static constexpr bool PERM = true;
    bf16_t* y2;
    DI void operator()(const f32x4 (&acc)[2][2][4][2], const pg8::Unit& u, int wr, int wc, int fr, int fq) const {
        const int col0 = u.pn * 256 + wc * 32 + 8 * fq;
#pragma unroll
        for (int ai = 0; ai < 2; ++ai)
#pragma unroll
            for (int m = 0; m < 4; ++m) { const int r = ai * 128 + wr * 64 + m * 16 + fr;
                if (r < u.nvalid) {
                    const int t2 = *(const int*)((const char*)u.rows + (size_t)r * 16);
                    const float gt = *(const float*)((const char*)u.rows + (size_t)r * 16 + 8);
                    bf16_t* rowp = y2 + (size_t)t2 * D + col0;
#pragma unroll
                    for (int bj = 0; bj < 2; ++bj) { const f32x4 v0 = acc[ai][bj][m][0] * gt, v1 = acc[ai][bj][m][1] * gt; u32x4 w;
                        w.x = pg8::cvt_pk_bf16(v0[0], v0[1]); w.y = pg8::cvt_pk_bf16(v0[2], v0[3]); w.z = pg8::cvt_pk_bf16(v1[0], v1[1]); w.w = pg8::cvt_pk_bf16(v1[2], v1[3]);
                        *(u32x4*)(rowp + bj * 128) = w; } } }
    }
};

#define XB_TMO      128
#define XB_XCNT(j)  (256  + 64 * (j))
#define XB_XSUB(j)  (1280 + 64 * (j))
#define XB_XGEN(j)  (2304 + 64 * (j))
#define XB_TOP      3328
#define XB_TOPGEN   3392
#define XCD_BAR_WORDS 3456
#define XB_SPIN_CAP (1u << 22)
__device__ __forceinline__ unsigned xb_ld(unsigned* p)              { return __hip_atomic_load(p, __ATOMIC_RELAXED, __HIP_MEMORY_SCOPE_AGENT); }
__device__ __forceinline__ unsigned xb_add(unsigned* p, unsigned v) { return __hip_atomic_fetch_add(p, v, __ATOMIC_RELAXED, __HIP_MEMORY_SCOPE_AGENT); }
__device__ __forceinline__ unsigned xb_xcc_id() { return (unsigned)__builtin_amdgcn_s_getreg((3 << 11) | 20) & 0xFu; }
#define XB_SPIN(cond, bar) do { unsigned _sp = 0; while (cond) { __builtin_amdgcn_s_sleep(1); \
    if ((++_sp & 255u) == 0u) { if (xb_ld(&(bar)[XB_TMO])) break; if (_sp > XB_SPIN_CAP) { atomicAdd(&(bar)[XB_TMO], 1u); break; } } } } while (0)
struct XcdBarrier { unsigned* bar; unsigned x; volatile LAS unsigned* st; };
__device__ __forceinline__ XcdBarrier xcd_barrier_post(unsigned* bar, volatile LAS unsigned* st) {
    XcdBarrier b; b.bar = bar; b.x = xb_xcc_id(); b.st = st;
    if (threadIdx.x == 0) (void)xb_add(&bar[XB_XCNT(b.x)], 1u);
    return b;
}
__device__ __forceinline__ void xcd_barrier_complete(unsigned* bar, unsigned x, unsigned& nloc, unsigned& nx) {
    const unsigned G = gridDim.x * gridDim.y * gridDim.z;
    unsigned sum, cnt, mine, sp = 0u;
    for (;;) {
        sum = 0u; cnt = 0u; mine = 0u;
#pragma unroll
        for (unsigned j = 0; j < 16; ++j) { const unsigned c = xb_ld(&bar[XB_XCNT(j)]); sum += c; cnt += (c > 0u) ? 1u : 0u; mine = (j == x) ? c : mine; }
        if (sum == G) break;
        __builtin_amdgcn_s_sleep(1);
        if ((++sp & 255u) == 0u) { if (xb_ld(&bar[XB_TMO])) break; if (sp > XB_SPIN_CAP) { atomicAdd(&bar[XB_TMO], 1u); break; } }
    }
    nloc = mine > 0u ? mine : 1u; nx = cnt > 0u ? cnt : 1u;
}
__device__ __forceinline__ void xcd_barrier(const XcdBarrier& b) {
    asm volatile("s_waitcnt vmcnt(0)" ::: "memory");
    __syncthreads();
    if (threadIdx.x == 0) {
        unsigned* bar = b.bar;
        __builtin_amdgcn_s_waitcnt(0);
        unsigned nloc = b.st[0], nx = b.st[1];
        if (nloc == 0u) { xcd_barrier_complete(bar, b.x, nloc, nx); b.st[0] = nloc; b.st[1] = nx; }
        const unsigned old = xb_add(&bar[XB_XSUB(b.x)], 1u);
        const unsigned gen = old / nloc;
        if (old + 1u == (gen + 1u) * nloc) {
            __builtin_amdgcn_fence(__ATOMIC_RELEASE, "agent");
            asm volatile("s_waitcnt vmcnt(0)" ::: "memory");
            const unsigned og = xb_add(&bar[XB_TOP], 1u);
            const unsigned tg = og / nx;
            if (og + 1u == (tg + 1u) * nx) xb_add(&bar[XB_TOPGEN], 1u);
            else XB_SPIN(xb_ld(&bar[XB_TOPGEN]) == tg, bar);
            __builtin_amdgcn_fence(__ATOMIC_ACQUIRE, "agent");
            xb_add(&bar[XB_XGEN(b.x)], 1u);
            asm volatile("s_waitcnt vmcnt(0)" ::: "memory");
        } else {
            XB_SPIN(xb_ld(&bar[XB_XGEN(b.x)]) == gen, bar);
            __builtin_amdgcn_fence(__ATOMIC_ACQUIRE, "agent");
            asm volatile("s_waitcnt vmcnt(0)" ::: "memory");
        }
    }
    __syncthreads();
}

struct Args { const float* in[25]; float* out; unsigned char* ws; int ph_lo, ph_hi; };
enum { I_X = 0, I_NMW, I_WIN, I_GCW, I_ALOG, I_DTB, I_GNW, I_RCW, I_RCB, I_WRG, I_BRG, I_WIG, I_BIG, I_LAM, I_RNW, I_WOUT, I_NFW, I_RWG, I_RBG, I_RWE, I_RBE, I_W1, I_W3, I_W2, I_NFIN };

constexpr int LDS_STAGE = 131072, LDS_BYTES = 147456, LDS_MISC = LDS_BYTES - 1024, LDS_TSTART = LDS_MISC + 256;

DI void transpose_item(const float* W, int ldw, bf16_t* WT, int ldt, LAS float* scr, int k0, int n0, int drow0, int lane) {
#pragma unroll 8
    for (int i = 0; i < 32; ++i) { const int kk = 2 * i + (lane >> 5); scr[kk * 33 + (lane & 31)] = W[(size_t)(k0 + kk) * ldw + n0 + (lane & 31)]; }
    asm volatile("s_waitcnt lgkmcnt(0)" ::: "memory");
    const int c = lane & 7;
#pragma unroll
    for (int j = 0; j < 4; ++j) { const int n = (lane >> 3) + 8 * j; const LAS float* s = scr + (8 * c) * 33 + n;
        u32x4 o; o.x = pk2(s[0 * 33], s[1 * 33]); o.y = pk2(s[2 * 33], s[3 * 33]); o.z = pk2(s[4 * 33], s[5 * 33]); o.w = pk2(s[6 * 33], s[7 * 33]);
        *(u32x4*)(WT + (size_t)(drow0 + n) * ldt + k0 + 8 * c) = o; }
    asm volatile("s_waitcnt lgkmcnt(0)" ::: "memory");
}

template <int PART>
DI void p0_weights(const Args& a, LAS unsigned char* lds, int gw, int NGW, int wave, int lane) {
    LAS float* scr = (LAS float*)(lds + wave * 16384);
    unsigned char* ws = a.ws;
    constexpr int S0 = 32 * 128, S1 = 32 * 64, S2 = 32 * 64, S3 = 32 * 512, S4 = S3, S5 = 32 * 512, S6 = 64, S7 = 64;
    constexpr int NITEMS = S0 + S1 + S2 + S3 + S4 + S5 + S6 + S7;
    constexpr int LO = PART == 0 ? 0 : S0 + S1 + S2, HI = PART == 0 ? S0 + S1 + S2 : S0 + S1 + S2 + S3 + S4 + S5, EX0 = NITEMS - S6 - S7;
    for (int it0 = gw; it0 < (HI - LO) + (PART == 0 ? S6 + S7 : 0); it0 += NGW) {
        int r = it0 < (HI - LO) ? LO + it0 : EX0 + (it0 - (HI - LO));
        if (r < S0) { const int kb = r / 128, nb = r % 128; transpose_item(a.in[I_WIN], INCOLS, (bf16_t*)(ws + WS_WIN), D, scr, kb * 64, nb * 32, nb * 32, lane); continue; } r -= S0;
        if (r < S1) { const int kb = r / 64, nb = r % 64; transpose_item(a.in[I_WIN] + 4112, INCOLS, (bf16_t*)(ws + WS_WIN), D, scr, kb * 64, nb * 32, 4096 + nb * 32, lane); continue; } r -= S1;
        if (r < S2) { const int kb = r / 64, nb = r % 64; transpose_item(a.in[I_WOUT], D, (bf16_t*)(ws + WS_WOUT), D, scr, kb * 64, nb * 32, nb * 32, lane); continue; } r -= S2;
        if (r < S3 + S4) { const int w3 = r >= S3; if (w3) r -= S3; const int e = r / 512, q = r % 512, kb = q / 16, nb = q % 16, n0 = nb * 32;
            const int drow = (n0 >> 7) * 256 + (n0 & 127) + (w3 ? 128 : 0);
            transpose_item(a.in[w3 ? I_W3 : I_W1] + (size_t)e * D * FF, FF, (bf16_t*)(ws + WS_W13) + (size_t)e * 1024 * D, D, scr, kb * 64, n0, drow, lane); continue; } r -= S3 + S4;
        if (r < S5) { const int e = r / 512, q = r % 512, kb = q / 64, nb = q % 64;
            transpose_item(a.in[I_W2] + (size_t)e * FF * D, D, (bf16_t*)(ws + WS_W2) + (size_t)e * D * FF, FF, scr, kb * 64, nb * 32, nb * 32, lane); continue; } r -= S5;
        { const int ig = r >= S6; if (ig) r -= S6; const int n = r / 8, q = r % 8, kb = q / 4, nb = q % 4;
            transpose_item(a.in[ig ? I_WIG : I_WRG] + (size_t)n * 128 * 128, 128, (bf16_t*)(ws + WS_WG) + (size_t)n * 256 * 128, 128, scr, kb * 64, nb * 32, nb * 32 + (ig ? 128 : 0), lane); }
    }
}

typedef float f32x4v __attribute__((ext_vector_type(4)));
template <int MODE>
DI void row_pass16(const Args& a, const float* X, const float* wn, bf16_t* XNb, float* RSTD, int row0, int lane, LAS float* lg  ) {
    constexpr int NT = MODE == 0 ? 1 : 3;
    const int c = lane & 15, g = lane >> 4;
    f32x4 acc[NT];
#pragma unroll
    for (int t = 0; t < NT; ++t) acc[t] = (f32x4){0.f, 0.f, 0.f, 0.f};
    float ss = 0.f;
    const float* xr = X + (size_t)(row0 + c) * D + 8 * g;
    bf16_t* xo = XNb + (size_t)(row0 + c) * D + 8 * g;
    const float* wsm0 = MODE == 0 ? a.in[I_WIN] + 4096 + c : a.in[I_RWE] + c;
    const float* wgrp = a.in[I_RWG] + (c < 4 ? c : 0);
    for (int S = 0; S < 64; ++S) {
        f32x4 x0 = *(const f32x4*)(xr + 32 * S), x1 = *(const f32x4*)(xr + 32 * S + 4);
        const f32x4 w0 = *(const f32x4*)(wn + 32 * S + 8 * g), w1 = *(const f32x4*)(wn + 32 * S + 8 * g + 4);
        ss += (x0[0] * x0[0] + x0[1] * x0[1]) + (x0[2] * x0[2] + x0[3] * x0[3]) + (x1[0] * x1[0] + x1[1] * x1[1]) + (x1[2] * x1[2] + x1[3] * x1[3]);
        x0 = x0 * w0; x1 = x1 * w1;
        u32x4 o; o.x = pk2(x0[0], x0[1]); o.y = pk2(x0[2], x0[3]); o.z = pk2(x1[0], x1[1]); o.w = pk2(x1[2], x1[3]);
        *(u32x4*)(xo + 32 * S) = o;
#pragma unroll
        for (int e = 0; e < 8; ++e) {
            const int k = 32 * S + 8 * g + e; const float av = e < 4 ? x0[e & 3] : x1[e & 3];
            if (MODE == 0) { const float b = wsm0[(size_t)k * INCOLS]; acc[0] = __builtin_amdgcn_mfma_f32_16x16x4f32(av, b, acc[0], 0, 0, 0); }
            else { const float b0 = wsm0[(size_t)k * 32], b1 = wsm0[(size_t)k * 32 + 16]; float b2 = wgrp[(size_t)k * 4]; b2 = c < 4 ? b2 : 0.f;
                acc[0] = __builtin_amdgcn_mfma_f32_16x16x4f32(av, b0, acc[0], 0, 0, 0); acc[1] = __builtin_amdgcn_mfma_f32_16x16x4f32(av, b1, acc[1], 0, 0, 0);
                if (NT > 2) acc[NT - 1] = __builtin_amdgcn_mfma_f32_16x16x4f32(av, b2, acc[NT - 1], 0, 0, 0); }
        }
    }
    ss += __shfl_xor(ss, 16); ss += __shfl_xor(ss, 32);
    const float rstd = rsqrtf(ss * (1.f / D) + EPS);
    if (g == 0) RSTD[row0 + c] = rstd;
    float rs[4];
#pragma unroll
    for (int r = 0; r < 4; ++r) rs[r] = __shfl(rstd, 4 * g + r);
    if (MODE == 0) {
        const int hh = c & 7; const float al = __expf(a.in[I_ALOG][hh]), dtb = a.in[I_DTB][hh];
        float* BETA = (float*)(a.ws + WS_BETA); float* GG = (float*)(a.ws + WS_G);
#pragma unroll
        for (int r = 0; r < 4; ++r) { const float v = rs[r] * acc[0][r]; const int row = row0 + 4 * g + r;
            if (c < 8) BETA[(size_t)row * 8 + hh] = sigmoidf_(v); else GG[(size_t)row * 8 + hh] = -al * softplusf_(v + dtb); }
    } else {
        const float be0 = a.in[I_RBE][c], be1 = a.in[I_RBE][16 + c], bg = a.in[I_RBG][c < 4 ? c : 0];
#pragma unroll
        for (int r = 0; r < 4; ++r) { const int rr = 4 * g + r; lg[rr * 40 + c] = rs[r] * acc[0][r] + be0; lg[rr * 40 + 16 + c] = rs[r] * acc[1][r] + be1; if (c < 4) lg[rr * 40 + 32 + c] = rs[r] * acc[NT - 1][r] + bg; }
        asm volatile("s_waitcnt lgkmcnt(0)" ::: "memory");
        if (lane < 16) {
            const LAS float* L = lg + lane * 40; const int token = row0 + lane;
            float gm = L[32]; int gi = 0;
#pragma unroll
            for (int q = 1; q < 4; ++q) if (L[32 + q] > gm) { gm = L[32 + q]; gi = q; }
            float gs = 0.f;
#pragma unroll
            for (int q = 0; q < 4; ++q) gs += __expf(L[32 + q] - gm);
            const float gp = 1.f / gs;
            float ev[8];
#pragma unroll
            for (int q = 0; q < 8; ++q) ev[q] = L[gi * 8 + q];
            float m1 = ev[0]; int i1 = 0;
#pragma unroll
            for (int q = 1; q < 8; ++q) if (ev[q] > m1) { m1 = ev[q]; i1 = q; }
            float m2 = -3.0e38f; int i2 = 0;
#pragma unroll
            for (int q = 0; q < 8; ++q) if (q != i1 && ev[q] > m2) { m2 = ev[q]; i2 = q; }
            const float p2 = __expf(m2 - m1), den = 1.f / (1.f + p2);
            const float g1 = gp * den, g2 = gp * p2 * den;
            int* cnt = (int*)(a.ws + WS_CTL) + CW_CNT; const float myr = rstd;
            const int e1 = gi * 8 + i1, e2 = gi * 8 + i2;
            const int s1 = atomicAdd(cnt + e1, 1), s2 = atomicAdd(cnt + e2, 1);
            f32x4* l1 = (f32x4*)(a.ws + WS_LIST + ((size_t)e1 * 16384 + s1) * 16); f32x4* l2 = (f32x4*)(a.ws + WS_LIST + ((size_t)e2 * 16384 + s2) * 16);
            *l1 = (f32x4){__int_as_float(token * 2), myr, g1, 0.f}; *l2 = (f32x4){__int_as_float(token * 2 + 1), myr, g2, 0.f};
        }
        asm volatile("s_waitcnt lgkmcnt(0)" ::: "memory");
    }
}

DI void final_row(const float* x1, const bf16_t* y2, const float* w, float* out, int row, int lane) {
    const f32x4* xr = (const f32x4*)(x1 + (size_t)row * D) + lane;
    const u32x2* ya = (const u32x2*)(y2 + (size_t)(2 * row) * D) + lane; const u32x2* yb = (const u32x2*)(y2 + (size_t)(2 * row + 1) * D) + lane;
    f32x4 v[8]; float ss = 0.f;
#pragma unroll
    for (int j = 0; j < 8; ++j) { const f32x4 x = xr[64 * j]; const u32x2 p = ya[64 * j], q = yb[64 * j];
        v[j] = (f32x4){x[0] + bflo(p.x) + bflo(q.x), x[1] + bfhi(p.x) + bfhi(q.x), x[2] + bflo(p.y) + bflo(q.y), x[3] + bfhi(p.y) + bfhi(q.y)};
        ss += (v[j][0] * v[j][0] + v[j][1] * v[j][1]) + (v[j][2] * v[j][2] + v[j][3] * v[j][3]); }
    const float rstd = rsqrtf(wave_sum(ss) * (1.f / D) + EPS);
    f32x4* o = (f32x4*)(out + (size_t)row * D) + lane; const f32x4* wr = (const f32x4*)w + lane;
#pragma unroll
    for (int j = 0; j < 8; ++j) o[64 * j] = v[j] * rstd * wr[64 * j];
}

DI void naive_gdn(const Args& a, LAS unsigned char* lds, int bh, int tid) {
    LAS float (*sq)[128] = (LAS float (*)[128])(lds), (*sk)[128] = (LAS float (*)[128])(lds + 8192), (*sv)[128] = (LAS float (*)[128])(lds + 16384);
    LAS float (*red)[128] = (LAS float (*)[128])(lds + 24576), (*red2)[128] = (LAS float (*)[128])(lds + 26624);
    const int b = bh >> 3, h = bh & 7, lane = tid & 63, wave = tid >> 6;
    const bf16_t* P = (const bf16_t*)(a.ws + WS_PROJ);
    const float* gcw = a.in[I_GCW]; const float* BETA = (const float*)(a.ws + WS_BETA); const float* GG = (const float*)(a.ws + WS_G);
    float* ORAW = (float*)(a.ws + WS_ORAW);
    const int dvi = tid & 127, dkg = tid >> 7;
    float S[32];
#pragma unroll
    for (int j = 0; j < 32; ++j) S[j] = 0.f;
    for (int t0 = 0; t0 < T; t0 += 16) {
        for (int idx = tid; idx < 16 * 384; idx += 512) {
            const int tok = idx / 384, ch = idx % 384, which = ch >> 7, d = ch & 127, col = h * 128 + d, tt = t0 + tok;
            const bf16_t* src = P + (size_t)which * (PROJ_STRIDE / 2);
            float acc = 0.f;
#pragma unroll
            for (int j = 0; j < 4; ++j) { const int ts = tt - 3 + j; if (ts >= 0) acc += gcw[j * 3072 + which * 1024 + col] * bf2f(src[(size_t)(b * T + ts) * 1024 + col]); }
            const float v = siluf_(acc);
            if (which == 0) sq[tok][d] = v; else if (which == 1) sk[tok][d] = v; else sv[tok][d] = v;
        }
        __syncthreads();
        for (int q = wave; q < 32; q += 8) { const int tok = q >> 1; LAS float* p = (q & 1) ? sk[tok] : sq[tok];
            const float v0 = p[lane], v1 = p[lane + 64]; const float ss = wave_sum(v0 * v0 + v1 * v1);
            const float sc = rsqrtf(ss + EPS) * ((q & 1) ? 1.f : 0.08838834764831845f); p[lane] = v0 * sc; p[lane + 64] = v1 * sc; }
        __syncthreads();
        for (int tok = 0; tok < 16; ++tok) {
            const size_t row = (size_t)b * T + t0 + tok;
            const float eg = __expf(GG[row * 8 + h]), bt = BETA[row * 8 + h];
            float p = 0.f;
#pragma unroll
            for (int j = 0; j < 32; ++j) { S[j] *= eg; p += S[j] * sk[tok][dkg * 32 + j]; }
            red[dkg][dvi] = p;
            __syncthreads();
            const float kv = (red[0][dvi] + red[1][dvi]) + (red[2][dvi] + red[3][dvi]);
            const float delta = bt * (sv[tok][dvi] - kv);
            float po = 0.f;
#pragma unroll
            for (int j = 0; j < 32; ++j) { S[j] += sk[tok][dkg * 32 + j] * delta; po += S[j] * sq[tok][dkg * 32 + j]; }
            red2[dkg][dvi] = po;
            __syncthreads();
            if (dkg == 0) ORAW[row * 1024 + h * 128 + dvi] = (red2[0][dvi] + red2[1][dvi]) + (red2[2][dvi] + red2[3][dvi]);
        }
        __syncthreads();
    }
}
DI void naive_gdn_final(const Args& a, int gwv, int lane) {
    const int row = gwv >> 3, h = gwv & 7;
    const float* o = (const float*)(a.ws + WS_ORAW) + (size_t)row * 1024 + h * 128;
    const bf16_t* z = (const bf16_t*)(a.ws + WS_PROJ + 3 * PROJ_STRIDE) + (size_t)row * 1024 + h * 128;
    bf16_t* mix = (bf16_t*)(a.ws + WS_MIX) + (size_t)row * D + h * 128;
    const float v0 = o[lane], v1 = o[lane + 64]; const float rstd = rsqrtf(wave_sum(v0 * v0 + v1 * v1) * (1.f / 128.f) + EPS);
    mix[lane] = (bf16_t)f2bf(v0 * rstd * a.in[I_GNW][lane] * siluf_(bf2f(z[lane])));
    mix[lane + 64] = (bf16_t)f2bf(v1 * rstd * a.in[I_GNW][lane + 64] * siluf_(bf2f(z[lane + 64])));
}
DI void naive_rg_gates(const Args& a, LAS unsigned char* lds, int blk, int tid) {
    LAS float (*xc)[128] = (LAS float (*)[128])(lds);
    const int n = blk & 7, r0 = (blk >> 3) * 32;
    const bf16_t* RX = (const bf16_t*)(a.ws + WS_PROJ + 4 * PROJ_STRIDE);
    float* RA = (float*)(a.ws + WS_RGA); float* RB = (float*)(a.ws + WS_RGB);
    __syncthreads();
    for (int idx = tid; idx < 4096; idx += 512) { const int tok = idx >> 7, i = idx & 127, ch = n * 128 + i, row = r0 + tok, t = row % T;
        float acc = a.in[I_RCB][ch];
#pragma unroll
        for (int j = 0; j < 4; ++j) { const int ts = t - 3 + j; if (ts >= 0) acc += a.in[I_RCW][j * 1024 + ch] * bf2f(RX[(size_t)(row - 3 + j) * 1024 + ch]); }
        xc[tok][i] = acc; }
    __syncthreads();
    const int j = tid & 127, q4 = tid >> 7, ch = n * 128 + j;
    const float* Wr = a.in[I_WRG] + (size_t)n * 16384; const float* Wi = a.in[I_WIG] + (size_t)n * 16384;
    const float sp = softplusf_(-a.in[I_LAM][ch]);
    for (int tok = q4 * 8; tok < q4 * 8 + 8; ++tok) {
        float ar = a.in[I_BRG][ch], ai = a.in[I_BIG][ch];
        for (int i = 0; i < 128; ++i) { const float x = xc[tok][i]; ar += x * Wr[i * 128 + j]; ai += x * Wi[i * 128 + j]; }
        const float r = sigmoidf_(ar), ig = sigmoidf_(ai), la = -8.f * r * sp, av = __expf(la), mult = sqrtf(-expm1f(2.f * la));
        RA[(size_t)(r0 + tok) * 1024 + ch] = av; RB[(size_t)(r0 + tok) * 1024 + ch] = mult * ig * xc[tok][j]; }
}
DI void naive_rg_scan(const Args& a, int id) {
    const int b = id >> 10, ch = id & 1023;
    float* RA = (float*)(a.ws + WS_RGA); const float* RB = (const float*)(a.ws + WS_RGB);
    const bf16_t* RG = (const bf16_t*)(a.ws + WS_PROJ + 5 * PROJ_STRIDE);
    float h = 0.f;
    for (int t = 0; t < T; ++t) { const size_t o = (size_t)(b * T + t) * 1024 + ch; h = RA[o] * h + RB[o]; RA[o] = h * gelu_tanh(bf2f(RG[o])); }
}
DI void naive_rg_norm(const Args& a, int gwv, int lane) {
    const int row = gwv >> 3, n = gwv & 7;
    const float* y = (const float*)(a.ws + WS_RGA) + (size_t)row * 1024 + n * 128;
    bf16_t* mix = (bf16_t*)(a.ws + WS_MIX) + (size_t)row * D + 1024 + n * 128;
    const float v0 = y[lane], v1 = y[lane + 64]; const float rstd = rsqrtf(wave_sum(v0 * v0 + v1 * v1) * (1.f / 128.f) + EPS);
    mix[lane] = (bf16_t)f2bf(v0 * rstd * a.in[I_RNW][n * 128 + lane]); mix[lane + 64] = (bf16_t)f2bf(v1 * rstd * a.in[I_RNW][n * 128 + lane + 64]);
}

constexpr int GP_GC = 0, GP_BT = 256, GP_KB = 1024, GP_QB = GP_KB + 17408, GP_VBT = GP_QB + 17408, GP_KBT = GP_VBT + 18432, GP_KDT = GP_KBT + 18432, GP_AM = GP_KDT + 16384, GP_TM = GP_AM + 16384;
DI void gdn_prep(const Args& a, LAS unsigned char* lds, int uid, int tid) {
    const int lane = tid & 63, w = __builtin_amdgcn_readfirstlane(tid >> 6), fr = lane & 15, fq = lane >> 4;
    const int n = uid & 127, bh = uid >> 7, h = bh & 7, b = bh >> 3;
    const size_t row0 = (size_t)b * T + (size_t)n * 64;
    LAS float* gc = (LAS float*)(lds + GP_GC); LAS float* bt = (LAS float*)(lds + GP_BT);
    LAS unsigned char* Kb = lds + GP_KB; LAS unsigned char* Qb = lds + GP_QB; LAS unsigned char* VbT = lds + GP_VBT; LAS unsigned char* KbT = lds + GP_KBT; LAS unsigned char* KdT = lds + GP_KDT;
    LAS float* Am = (LAS float*)(lds + GP_AM); LAS unsigned char* Tm = lds + GP_TM;
    const float* BETA = (const float*)(a.ws + WS_BETA); const float* GG = (const float*)(a.ws + WS_G);
    const bf16_t* P = (const bf16_t*)(a.ws + WS_PROJ);
    bf16_t* QG = (bf16_t*)(a.ws + WS_QG) + (size_t)uid * 8192; bf16_t* KDT = (bf16_t*)(a.ws + WS_KDT) + (size_t)uid * 8192;
    bf16_t* UU = (bf16_t*)(a.ws + WS_U) + (size_t)uid * 8192; bf16_t* WN = (bf16_t*)(a.ws + WS_WN) + (size_t)uid * 8192; bf16_t* AT = (bf16_t*)(a.ws + WS_AT) + (size_t)uid * 4096;
    __syncthreads();
    if (w == 0) { float c = GG[(row0 + lane) * 8 + h];
#pragma unroll
        for (int o = 1; o < 64; o <<= 1) { const float v = __shfl_up(c, o); if (lane >= o) c += v; }
        gc[lane] = c; bt[lane] = BETA[(row0 + lane) * 8 + h]; if (lane == 63) ((float*)(a.ws + WS_GAM))[uid] = __expf(c); }
    __syncthreads();
    { const int c8 = tid & 15, r = tid >> 4; const float glast = gc[63];
#pragma unroll
      for (int q2 = 0; q2 < 2; ++q2) {
        const int i = r + 32 * q2, t = n * 64 + i; const size_t row = row0 + i;
        float val[3][8];
#pragma unroll
        for (int wh = 0; wh < 3; ++wh) {
            float acc[8];
#pragma unroll
            for (int e = 0; e < 8; ++e) acc[e] = 0.f;
#pragma unroll
            for (int j = 0; j < 4; ++j) { if (t - 3 + j >= 0) { const u32x4 raw = *(const u32x4*)(P + (size_t)wh * (PROJ_STRIDE / 2) + (row - 3 + j) * 1024 + h * 128 + 8 * c8);
                const float* cw = a.in[I_GCW] + j * 3072 + wh * 1024 + h * 128 + 8 * c8;
#pragma unroll
                for (int i2 = 0; i2 < 4; ++i2) { acc[2 * i2] += cw[2 * i2] * bflo(raw[i2]); acc[2 * i2 + 1] += cw[2 * i2 + 1] * bfhi(raw[i2]); } } }
#pragma unroll
            for (int e = 0; e < 8; ++e) val[wh][e] = siluf_(acc[e]);
        }
        float ssq = 0.f, ssk = 0.f;
#pragma unroll
        for (int e = 0; e < 8; ++e) { ssq += val[0][e] * val[0][e]; ssk += val[1][e] * val[1][e]; }
#pragma unroll
        for (int o = 1; o < 16; o <<= 1) { ssq += __shfl_xor(ssq, o); ssk += __shfl_xor(ssk, o); }
        const float qs = rsqrtf(ssq + EPS) * 0.08838834764831845f, ks = rsqrtf(ssk + EPS);
        const float gci = gc[i], ei = __expf(gci), bi = bt[i], ed = __expf(glast - gci);
        float qh[8], kh[8];
#pragma unroll
        for (int e = 0; e < 8; ++e) { qh[e] = val[0][e] * qs; kh[e] = val[1][e] * ks; }
        u32x4 o;
        o.x = pk2(qh[0], qh[1]); o.y = pk2(qh[2], qh[3]); o.z = pk2(qh[4], qh[5]); o.w = pk2(qh[6], qh[7]); *(LAS u32x4*)(Qb + i * 272 + 16 * c8) = o;
        o.x = pk2(kh[0], kh[1]); o.y = pk2(kh[2], kh[3]); o.z = pk2(kh[4], kh[5]); o.w = pk2(kh[6], kh[7]); *(LAS u32x4*)(Kb + i * 272 + 16 * c8) = o;
        o.x = pk2(qh[0] * ei, qh[1] * ei); o.y = pk2(qh[2] * ei, qh[3] * ei); o.z = pk2(qh[4] * ei, qh[5] * ei); o.w = pk2(qh[6] * ei, qh[7] * ei); *(u32x4*)(QG + i * 128 + 8 * c8) = o;
#pragma unroll
        for (int e = 0; e < 8; ++e) { const int d = 8 * c8 + e;
            *(LAS bf16_t*)(KbT + d * 144 + 2 * i) = (bf16_t)f2bf(kh[e] * bi * ei);
            *(LAS bf16_t*)(VbT + d * 144 + 2 * i) = (bf16_t)f2bf(val[2][e] * bi);
            *(LAS bf16_t*)(KdT + d * 128 + 2 * i) = (bf16_t)f2bf(kh[e] * ed); }
      } }
    __syncthreads();
    { const int mat = w >> 2, it = w & 3; LAS unsigned char* Ab = mat ? Qb : Kb;
      bf16x8 Afr[4];
#pragma unroll
      for (int ks = 0; ks < 4; ++ks) Afr[ks] = *(const LAS bf16x8*)(Ab + (16 * it + fr) * 272 + (32 * ks + 8 * fq) * 2);
#pragma unroll
      for (int jt = 0; jt < 4; ++jt) {
        f32x4 acc = (f32x4){0.f, 0.f, 0.f, 0.f};
        if (jt <= it) {
#pragma unroll
            for (int ks = 0; ks < 4; ++ks) acc = __builtin_amdgcn_mfma_f32_16x16x32_bf16(Afr[ks], *(const LAS bf16x8*)(Kb + (16 * jt + fr) * 272 + (32 * ks + 8 * fq) * 2), acc, 0, 0, 0);
        }
        const int j = 16 * jt + fr; const float gcj = gc[j];
#pragma unroll
        for (int r = 0; r < 4; ++r) { const int i = 16 * it + 4 * fq + r; const float dec = __expf(fminf(gc[i] - gcj, 0.f));
            if (mat == 0) Am[i * 64 + j] = (i > j) ? bt[i] * acc[r] * dec : 0.f;
            else AT[i * 64 + j] = (bf16_t)f2bf((i >= j) ? acc[r] * dec : 0.f); }
      } }
#pragma unroll
    for (int q2 = 0; q2 < 2; ++q2) { const int pc = tid + 512 * q2; *(u32x4*)(KDT + pc * 8) = *(const LAS u32x4*)(KdT + pc * 16); }
    __syncthreads();
    if (w == 0) {
        float Tc[64]; int lz = lane; asm volatile("" : "+v"(lz));
#pragma unroll
        for (int i = 0; i < 64; ++i) { float acc = (i == lz) ? 1.f : 0.f;
#pragma unroll
            for (int j = 0; j < i; ++j) acc -= Am[i * 64 + j] * Tc[j];
            Tc[i] = acc; }
#pragma unroll
        for (int i = 0; i < 64; ++i) *(LAS bf16_t*)(Tm + i * 144 + 2 * lane) = (bf16_t)f2bf(Tc[i]);
    }
    __syncthreads();
    { const int mat = w >> 2, it = w & 3; LAS unsigned char* Xb = mat ? KbT : VbT; bf16_t* Og = mat ? WN : UU; const float sg = mat ? -1.f : 1.f;
      bf16x8 Tfr[2];
#pragma unroll
      for (int ks = 0; ks < 2; ++ks) Tfr[ks] = *(const LAS bf16x8*)(Tm + (16 * it + fr) * 144 + (32 * ks + 8 * fq) * 2);
#pragma unroll
      for (int dt = 0; dt < 8; ++dt) {
        f32x4 acc = (f32x4){0.f, 0.f, 0.f, 0.f};
#pragma unroll
        for (int ks = 0; ks < 2; ++ks) acc = __builtin_amdgcn_mfma_f32_16x16x32_bf16(Tfr[ks], *(const LAS bf16x8*)(Xb + (16 * dt + fr) * 144 + (32 * ks + 8 * fq) * 2), acc, 0, 0, 0);
#pragma unroll
        for (int r = 0; r < 4; ++r) Og[(16 * it + 4 * fq + r) * 128 + 16 * dt + fr] = (bf16_t)f2bf(sg * acc[r]);
      } }
}

constexpr int GS_WN = 0, GS_QG = 17408, GS_AT = 34816, GS_KDT = 44032, GS_U = 62464, GS_BUF = 67584, GS_GAM = 2 * GS_BUF;
DI void gs_piece(int pc, int uid, int q4, const unsigned char* ws, const bf16_t*& src, int& dst) {
    if (pc < 1024) { const int row = pc >> 4, c = pc & 15; src = (const bf16_t*)(ws + WS_WN) + (size_t)uid * 8192 + row * 128 + c * 8; dst = GS_WN + row * 272 + c * 16; }
    else if (pc < 2048) { const int p2 = pc - 1024, row = p2 >> 4, c = p2 & 15; src = (const bf16_t*)(ws + WS_QG) + (size_t)uid * 8192 + row * 128 + c * 8; dst = GS_QG + row * 272 + c * 16; }
    else if (pc < 2560) { const int p2 = pc - 2048, row = p2 >> 3, c = p2 & 7; src = (const bf16_t*)(ws + WS_AT) + (size_t)uid * 4096 + row * 64 + c * 8; dst = GS_AT + row * 144 + c * 16; }
    else if (pc < 3584) { const int p2 = pc - 2560, row = p2 >> 3, c = p2 & 7; src = (const bf16_t*)(ws + WS_KDT) + (size_t)uid * 8192 + row * 64 + c * 8; dst = GS_KDT + row * 144 + c * 16; }
    else { const int p2 = pc - 3584, row = p2 >> 2, c = p2 & 3; src = (const bf16_t*)(ws + WS_U) + (size_t)uid * 8192 + row * 128 + q4 * 32 + c * 8; dst = GS_U + row * 80 + c * 16; }
}
DI bf16x8 gs_lda(const LAS unsigned char* base, int row, int stride, int k0, int fq) {
    const u32x2 lo = *(const LAS u32x2*)(base + row * stride + (k0 + 4 * fq) * 2), hi = *(const LAS u32x2*)(base + row * stride + (k0 + 16 + 4 * fq) * 2);
    u32x4 v; v.x = lo.x; v.y = lo.y; v.z = hi.x; v.w = hi.y; return __builtin_bit_cast(bf16x8, v);
}
DI bf16x8 gs_pack(const f32x4& lo, const f32x4& hi) {
    u32x4 v; v.x = pg8::cvt_pk_bf16(lo[0], lo[1]); v.y = pg8::cvt_pk_bf16(lo[2], lo[3]); v.z = pg8::cvt_pk_bf16(hi[0], hi[1]); v.w = pg8::cvt_pk_bf16(hi[2], hi[3]); return __builtin_bit_cast(bf16x8, v);
}
DI void gdn_scan(const Args& a, LAS unsigned char* lds, int su, int tid) {
    const int lane = tid & 63, w = __builtin_amdgcn_readfirstlane(tid >> 6), fr = lane & 15, fq = lane >> 4;
    const int q4 = su & 3, bh = su >> 2, h = bh & 7, b = bh >> 3, uid0 = bh * 128;
    const int lt = tid - 128;
    bf16_t* ORAW = (bf16_t*)(a.ws + WS_ORAW);
    const float* GAM = (const float*)(a.ws + WS_GAM);
    LAS float* gaml = (LAS float*)(lds + GS_GAM);
    __syncthreads();
    if (w >= 2) {
#pragma unroll
        for (int k = 0; k < 10; ++k) { const bf16_t* src; int dst; gs_piece(lt + 384 * k, uid0, q4, a.ws, src, dst); *(LAS u32x4*)(lds + dst) = *(const u32x4*)src; }
        if (lt == 0) gaml[0] = GAM[uid0];
    }
    f32x4 S[8];
#pragma unroll
    for (int kt = 0; kt < 8; ++kt) S[kt] = (f32x4){0.f, 0.f, 0.f, 0.f};
    __syncthreads();
    for (int c = 0; c < 128; ++c) {
        LAS unsigned char* Bf = lds + (c & 1) * GS_BUF;
        if (w >= 2) {
            if (c + 1 < 128) {
                LAS unsigned char* Nb = lds + ((c + 1) & 1) * GS_BUF; u32x4 v[10]; int dsts[10];
#pragma unroll
                for (int k = 0; k < 10; ++k) { const bf16_t* src; gs_piece(lt + 384 * k, uid0 + c + 1, q4, a.ws, src, dsts[k]); v[k] = *(const u32x4*)src; }
#pragma unroll
                for (int k = 0; k < 10; ++k) *(LAS u32x4*)(Nb + dsts[k]) = v[k];
                if (lt == 0) gaml[(c + 1) & 1] = GAM[uid0 + c + 1];
            }
        } else {
            const size_t rowc = (size_t)b * T + (size_t)c * 64;
            bf16x8 Sb[4];
#pragma unroll
            for (int ks = 0; ks < 4; ++ks) Sb[ks] = gs_pack(S[2 * ks], S[2 * ks + 1]);
            f32x4 vn[4], o[4];
#pragma unroll
            for (int mt = 0; mt < 4; ++mt) {
#pragma unroll
                for (int r = 0; r < 4; ++r) vn[mt][r] = bf2f(*(const LAS bf16_t*)(Bf + GS_U + (16 * mt + 4 * fq + r) * 80 + (16 * w + fr) * 2));
                o[mt] = (f32x4){0.f, 0.f, 0.f, 0.f};
#pragma unroll
                for (int ks = 0; ks < 4; ++ks) {
                    vn[mt] = __builtin_amdgcn_mfma_f32_16x16x32_bf16(gs_lda(Bf + GS_WN, 16 * mt + fr, 272, 32 * ks, fq), Sb[ks], vn[mt], 0, 0, 0);
                    o[mt] = __builtin_amdgcn_mfma_f32_16x16x32_bf16(gs_lda(Bf + GS_QG, 16 * mt + fr, 272, 32 * ks, fq), Sb[ks], o[mt], 0, 0, 0);
                }
            }
            bf16x8 Vb[2];
#pragma unroll
            for (int js = 0; js < 2; ++js) Vb[js] = gs_pack(vn[2 * js], vn[2 * js + 1]);
#pragma unroll
            for (int mt = 0; mt < 4; ++mt) {
#pragma unroll
                for (int js = 0; js < 2; ++js) o[mt] = __builtin_amdgcn_mfma_f32_16x16x32_bf16(gs_lda(Bf + GS_AT, 16 * mt + fr, 144, 32 * js, fq), Vb[js], o[mt], 0, 0, 0);
#pragma unroll
                for (int r = 0; r < 4; ++r) ORAW[(rowc + 16 * mt + 4 * fq + r) * 1024 + h * 128 + q4 * 32 + 16 * w + fr] = (bf16_t)f2bf(o[mt][r]);
            }
            const float gam = gaml[c & 1];
#pragma unroll
            for (int kt = 0; kt < 8; ++kt) { S[kt] = S[kt] * gam;
#pragma unroll
                for (int js = 0; js < 2; ++js) S[kt] = __builtin_amdgcn_mfma_f32_16x16x32_bf16(gs_lda(Bf + GS_KDT, 16 * kt + fr, 144, 32 * js, fq), Vb[js], S[kt], 0, 0, 0); }
        }
        __syncthreads();
    }
}
DI void gdn_final(const Args& a, int gwv, int lane) {
    const int row = gwv >> 3, h = gwv & 7;
    const bf16_t* o = (const bf16_t*)(a.ws + WS_ORAW) + (size_t)row * 1024 + h * 128;
    const bf16_t* z = (const bf16_t*)(a.ws + WS_PROJ + 3 * PROJ_STRIDE) + (size_t)row * 1024 + h * 128;
    bf16_t* mix = (bf16_t*)(a.ws + WS_MIX) + (size_t)row * D + h * 128;
    const unsigned ov = *((const unsigned*)o + lane), zv = *((const unsigned*)z + lane);
    const float v0 = bflo(ov), v1 = bfhi(ov); const float rstd = rsqrtf(wave_sum(v0 * v0 + v1 * v1) * (1.f / 128.f) + EPS);
    const f32x2 wv = *((const f32x2*)a.in[I_GNW] + lane);
    *((unsigned*)mix + lane) = pk2(v0 * rstd * wv.x * siluf_(bflo(zv)), v1 * rstd * wv.y * siluf_(bfhi(zv)));
}

template <int PASS>
DI void rg_unit(const Args& a, LAS unsigned char* lds, int unit, int tid) {
    const int lane = tid & 63, w = tid >> 6, fr = lane & 15, fq = lane >> 4;
    const int cg = unit & 3, tc = (unit >> 2) & 31, b = unit >> 7;
    const int n = cg * 2 + (w >> 2), jb = 32 * (w & 3), wb = (w >> 2) * 128;
    constexpr int XS = 528;
    LAS unsigned char* Xc = lds; LAS unsigned char* Gt = lds + 33792; LAS float* Ps = (LAS float*)(lds + 67584);
    const bf16_t* RX = (const bf16_t*)(a.ws + WS_PROJ + 4 * PROJ_STRIDE); const bf16_t* RG = (const bf16_t*)(a.ws + WS_PROJ + 5 * PROJ_STRIDE);
    bf16_t* MIX = (bf16_t*)(a.ws + WS_MIX);
    float* SUMA = (float*)(a.ws + WS_RGSUM); float* SUMH = SUMA + 2 * 32 * 1024;
    const int c8 = tid & 31, r16 = tid >> 5, chs = cg * 256 + 8 * c8;
    bf16x8 Bw[2][2][4];
    { const bf16_t* Wg = (const bf16_t*)(a.ws + WS_WG) + (size_t)n * 256 * 128;
#pragma unroll
      for (int gt = 0; gt < 2; ++gt)
#pragma unroll
        for (int jt = 0; jt < 2; ++jt)
#pragma unroll
          for (int ks = 0; ks < 4; ++ks) Bw[gt][jt][ks] = *(const bf16x8*)(Wg + (size_t)(gt * 128 + jb + 16 * jt + fr) * 128 + 32 * ks + 8 * fq); }
    float sp[2], br[2], bi[2]; int chl[2];
#pragma unroll
    for (int jt = 0; jt < 2; ++jt) { chl[jt] = jb + 16 * jt + fr; const int ch = n * 128 + chl[jt]; sp[jt] = softplusf_(-a.in[I_LAM][ch]); br[jt] = a.in[I_BRG][ch]; bi[jt] = a.in[I_BIG][ch]; }
    float hin[2] = {0.f, 0.f}, Arun[2] = {1.f, 1.f}, Brun[2] = {0.f, 0.f};
    if (PASS == 1) {
        for (int tcp = 0; tcp < tc; ++tcp)
#pragma unroll
            for (int jt = 0; jt < 2; ++jt) { const size_t o = (size_t)(b * 32 + tcp) * 1024 + n * 128 + chl[jt]; hin[jt] = SUMA[o] * hin[jt] + SUMH[o]; }
    }
    for (int s = 0; s < 4; ++s) {
        const int t0 = tc * 256 + 64 * s;
        __syncthreads();
#pragma unroll
        for (int q = 0; q < 4; ++q) {
            const int tok = r16 + 16 * q, t = t0 + tok; const size_t row = (size_t)b * T + t;
            float xv[8];
#pragma unroll
            for (int e = 0; e < 8; ++e) xv[e] = a.in[I_RCB][chs + e];
#pragma unroll
            for (int j = 0; j < 4; ++j) { if (t - 3 + j >= 0) { const u32x4 raw = *(const u32x4*)(RX + (row - 3 + j) * 1024 + chs); const float* cwj = a.in[I_RCW] + j * 1024 + chs;
#pragma unroll
                for (int i = 0; i < 4; ++i) { xv[2 * i] += cwj[2 * i] * bflo(raw[i]); xv[2 * i + 1] += cwj[2 * i + 1] * bfhi(raw[i]); } } }
            u32x4 o; o.x = pk2(xv[0], xv[1]); o.y = pk2(xv[2], xv[3]); o.z = pk2(xv[4], xv[5]); o.w = pk2(xv[6], xv[7]);
            *(LAS u32x4*)(Xc + tok * XS + 16 * c8) = o;
            if (PASS == 1) *(LAS u32x4*)(Gt + tok * XS + 16 * c8) = *(const u32x4*)(RG + row * 1024 + chs);
        }
        __syncthreads();
        float pss[4][4];
#pragma unroll
        for (int m = 0; m < 4; ++m)
#pragma unroll
            for (int r = 0; r < 4; ++r) pss[m][r] = 0.f;
#pragma unroll
        for (int m = 0; m < 4; ++m) {
            bf16x8 Af[4];
#pragma unroll
            for (int ks = 0; ks < 4; ++ks) Af[ks] = *(const LAS bf16x8*)(Xc + (16 * m + fr) * XS + (wb + 32 * ks + 8 * fq) * 2);
            f32x4 acc[2][2];
#pragma unroll
            for (int gt = 0; gt < 2; ++gt)
#pragma unroll
                for (int jt = 0; jt < 2; ++jt) { acc[gt][jt] = (f32x4){0.f, 0.f, 0.f, 0.f};
#pragma unroll
                    for (int ks = 0; ks < 4; ++ks) acc[gt][jt] = __builtin_amdgcn_mfma_f32_16x16x32_bf16(Af[ks], Bw[gt][jt][ks], acc[gt][jt], 0, 0, 0); }
#pragma unroll
            for (int jt = 0; jt < 2; ++jt) {
                float av[4], bv[4];
#pragma unroll
                for (int r = 0; r < 4; ++r) { const int tl = 16 * m + 4 * fq + r;
                    const float xcv = bf2f(*(const LAS bf16_t*)(Xc + tl * XS + (wb + chl[jt]) * 2));
                    const float rr = sigmoidf_(acc[0][jt][r] + br[jt]), ii = sigmoidf_(acc[1][jt][r] + bi[jt]), la = -8.f * rr * sp[jt];
                    av[r] = __expf(la); bv[r] = sqrtf(-expm1f(2.f * la)) * ii * xcv; }
                float A = av[0], B = bv[0];
#pragma unroll
                for (int r = 1; r < 4; ++r) { B = B * av[r] + bv[r]; A *= av[r]; }
                float pA = __shfl_up(A, 16), pB = __shfl_up(B, 16); if (fq >= 1) { B = pB * A + B; A = pA * A; }
                pA = __shfl_up(A, 32); pB = __shfl_up(B, 32); if (fq >= 2) { B = pB * A + B; A = pA * A; }
                float Ae = __shfl_up(A, 16), Be = __shfl_up(B, 16); if (fq == 0) { Ae = 1.f; Be = 0.f; }
                const float At = __shfl(A, fr + 48), Bt = __shfl(B, fr + 48);
                if (PASS == 0) { Brun[jt] = At * Brun[jt] + Bt; Arun[jt] *= At; }
                else { float h = Ae * hin[jt] + Be;
#pragma unroll
                    for (int r = 0; r < 4; ++r) { const int tl = 16 * m + 4 * fq + r; h = av[r] * h + bv[r];
                        LAS bf16_t* gp = (LAS bf16_t*)(Gt + tl * XS + (wb + chl[jt]) * 2); const float y = h * gelu_tanh(bf2f(*gp)); *gp = (bf16_t)f2bf(y); pss[m][r] += y * y; }
                    hin[jt] = At * hin[jt] + Bt; }
            }
        }
        if (PASS == 1) {
#pragma unroll
            for (int m = 0; m < 4; ++m)
#pragma unroll
                for (int r = 0; r < 4; ++r) { float v = pss[m][r]; v += __shfl_xor(v, 1); v += __shfl_xor(v, 2); v += __shfl_xor(v, 4); v += __shfl_xor(v, 8); if (fr == 0) Ps[w * 64 + 16 * m + 4 * fq + r] = v; }
            __syncthreads();
            { const int w0 = 4 * (c8 >> 4); float nwv[8];
#pragma unroll
              for (int e = 0; e < 8; ++e) nwv[e] = a.in[I_RNW][chs + e];
#pragma unroll
              for (int q = 0; q < 4; ++q) { const int tok = r16 + 16 * q; const size_t row = (size_t)b * T + t0 + tok;
                const float tot = (Ps[w0 * 64 + tok] + Ps[(w0 + 1) * 64 + tok]) + (Ps[(w0 + 2) * 64 + tok] + Ps[(w0 + 3) * 64 + tok]);
                const float rstd = rsqrtf(tot * (1.f / 128.f) + EPS);
                const u32x4 yr = *(const LAS u32x4*)(Gt + tok * XS + 16 * c8); u32x4 o;
                o.x = pk2(bflo(yr.x) * rstd * nwv[0], bfhi(yr.x) * rstd * nwv[1]); o.y = pk2(bflo(yr.y) * rstd * nwv[2], bfhi(yr.y) * rstd * nwv[3]);
                o.z = pk2(bflo(yr.z) * rstd * nwv[4], bfhi(yr.z) * rstd * nwv[5]); o.w = pk2(bflo(yr.w) * rstd * nwv[6], bfhi(yr.w) * rstd * nwv[7]);
                *(u32x4*)(MIX + row * D + 1024 + chs) = o; } }
        }
    }
    if (PASS == 0 && fq == 0) {
#pragma unroll
        for (int jt = 0; jt < 2; ++jt) { const size_t o = (size_t)(b * 32 + tc) * 1024 + n * 128 + chl[jt]; SUMA[o] = Arun[jt]; SUMH[o] = Brun[jt]; }
    }
}

constexpr int NPHASES = 11;
__global__ void __launch_bounds__(NTHREADS, 2) fwd(Args a) {
    extern __shared__ __attribute__((aligned(16))) unsigned char lds_raw[];
    LAS unsigned char* lds = (LAS unsigned char*)lds_raw;
    const int tid = threadIdx.x, lane = tid & 63, wave = __builtin_amdgcn_readfirstlane(tid >> 6);
    const int G = gridDim.x, bx = blockIdx.x;
    const int vcu = (G % 8 == 0) ? (bx % 8) * (G / 8) + bx / 8 : bx;
    const int gw = vcu * NWAVES + wave, NGW = G * NWAVES;
    unsigned char* ws = a.ws;
    const int lo = a.ph_lo, hi = a.ph_hi;
    if (tid < 16) ((LAS unsigned*)(lds + LDS_MISC))[tid] = 0u;
    __syncthreads();
    XcdBarrier bar; bar.bar = (unsigned*)(ws + WS_CTL) + CW_BAR; bar.x = 0; bar.st = nullptr;
    if (hi - lo > 1) bar = xcd_barrier_post((unsigned*)(ws + WS_CTL) + CW_BAR, (volatile LAS unsigned*)(lds + LDS_MISC));
#define IN(k) (lo <= (k) && (k) < hi)
#define SEAM(k) do { if (IN(k) && IN((k) + 1)) xcd_barrier(bar); } while (0)
    if (IN(0)) {
        p0_weights<0>(a, lds, gw, NGW, wave, lane);
        for (int task = gw; task < M / 16; task += NGW) row_pass16<0>(a, a.in[I_X], a.in[I_NMW], (bf16_t*)(ws + WS_XN), (float*)(ws + WS_RSTD1), task * 16, lane, nullptr);
    }
    SEAM(0);
    if (IN(1)) {
        DenseSched S; S.init(ws + WS_XN, ws + WS_WIN, M, NPROJ, D, G, bx);
        EpiProj E{(bf16_t*)(ws + WS_PROJ), (const float*)(ws + WS_RSTD1)};
        pg8::gemm_phase<EpiProj, DenseSched, false>(lds, D, S, E);
    }
    SEAM(1);
    if (IN(2)) { for (int u = bx; u < 256; u += G) rg_unit<0>(a, lds, u, tid); for (int u = bx; u < 2048; u += G) gdn_prep(a, lds, u, tid); }
    SEAM(2);
    if (IN(3)) {
        if (bx < 64) gdn_scan(a, lds, bx, tid);
        else for (int u = bx - 64; u < 256; u += G - 64) rg_unit<1>(a, lds, u, tid);
    }
    SEAM(3);
    if (IN(4)) { for (int q = gw; q < M * 8; q += NGW) gdn_final(a, q, lane); __syncthreads(); p0_weights<1>(a, lds, gw, NGW, wave, lane); }
    SEAM(4);
    if (IN(5)) { }
    SEAM(5);
    if (IN(6)) {
        DenseSched S; S.init(ws + WS_MIX, ws + WS_WOUT, M, D, D, G, bx);
        EpiX1 E{a.in[I_X], (float*)(ws + WS_X1)};
        pg8::gemm_phase<EpiX1, DenseSched, false>(lds, D, S, E);
    }
    SEAM(6);
    if (IN(7)) {
        LAS float* lg = (LAS float*)(lds + wave * 4096);
        for (int task = gw; task < M / 16; task += NGW) row_pass16<1>(a, (const float*)(ws + WS_X1), a.in[I_NFW], (bf16_t*)(ws + WS_H2), (float*)(ws + WS_RSTD2), task * 16, lane, lg);
    }
    SEAM(7);
    if (IN(8) || IN(9)) {
        LAS int* tstart = (LAS int*)(lds + LDS_TSTART);
        const int* cnt = (const int*)(ws + WS_CTL) + CW_CNT;
        if (wave == 0) { const int cn = lane < 32 ? cnt[lane] : 0; const int ntl = (cn + 255) >> 8; int incl = ntl;
#pragma unroll
            for (int o = 1; o < 32; o <<= 1) { const int v = __shfl_up(incl, o); if (lane >= o) incl += v; }
            if (lane < 32) tstart[lane] = incl - ntl; if (lane == 31) tstart[32] = incl; }
        __syncthreads();
        if (IN(8)) {
            MoeSched S{(const char*)(ws + WS_H2), (const char*)(ws + WS_W13), D, 4, 1024, G, bx, 1, tstart, cnt, (const char*)(ws + WS_LIST)};
            EpiUp E{(bf16_t*)(ws + WS_HB)};
            pg8::gemm_phase<EpiUp, MoeSched, true>(lds, D, S, E);
        }
        SEAM(8);
        if (IN(9)) {
            MoeSched S{(const char*)(ws + WS_HB), (const char*)(ws + WS_W2), FF, 8, 2048, G, bx, 0, tstart, cnt, (const char*)(ws + WS_LIST)};
            EpiDown E{(bf16_t*)(ws + WS_Y2)};
            pg8::gemm_phase<EpiDown, MoeSched, false>(lds, FF, S, E);
        }
    }
    SEAM(9);
    if (IN(10)) {
        for (int row = gw; row < M; row += NGW) final_row((const float*)(ws + WS_X1), (const bf16_t*)(ws + WS_Y2), a.in[I_NFIN], a.out, row, lane);
    }
#undef IN
#undef SEAM
}

#ifndef N_LAUNCHES
#define N_LAUNCHES 1
#endif
extern "C" void kernel_launch(void* const* d_in, const int* in_sizes, int n_in, void* d_out, int out_size, void* d_ws, size_t ws_size, hipStream_t stream) {
    static int grid = 0;
    if (grid == 0) {
        if (n_in != 25 || ws_size < WS_END) { fprintf(stderr, "kernel_launch: unexpected n_in %d or ws_size %zu (< %zu)\n", n_in, ws_size, (size_t)WS_END); grid = -1; return; }
        int dev = 0, cus = 0; (void)hipGetDevice(&dev); (void)hipDeviceGetAttribute(&cus, hipDeviceAttributeMultiprocessorCount, dev);
        if (hipFuncSetAttribute((const void*)fwd, hipFuncAttributeMaxDynamicSharedMemorySize, LDS_BYTES) != hipSuccess) { fprintf(stderr, "kernel_launch: hipFuncSetAttribute failed\n"); grid = -1; return; }
        int per_cu = 0; (void)hipOccupancyMaxActiveBlocksPerMultiprocessor(&per_cu, (const void*)fwd, NTHREADS, LDS_BYTES); (void)hipGetLastError();
        if (per_cu < 1) fprintf(stderr, "kernel_launch: occupancy query reports %d blocks per CU\n", per_cu);
        grid = cus > 0 ? cus : 256;
    }
    if (grid < 0) return;
    (void)hipMemsetAsync((char*)d_ws + WS_CTL, 0, CTL_BYTES, stream);
    Args a{};
    for (int i = 0; i < 25; ++i) a.in[i] = (const float*)d_in[i];
    a.out = (float*)d_out; a.ws = (unsigned char*)d_ws;
    if (N_LAUNCHES == 1) { a.ph_lo = 0; a.ph_hi = NPHASES; hipLaunchKernelGGL(fwd, dim3(grid), dim3(NTHREADS), LDS_BYTES, stream, a); }
    else for (int p = 0; p < NPHASES; ++p) { a.ph_lo = p; a.ph_hi = p + 1; hipLaunchKernelGGL(fwd, dim3(grid), dim3(NTHREADS), LDS_BYTES, stream, a); }
}
```

```cpp
#include <hip/hip_runtime.h>
#include <cstdio>
#include <cstdint>

#define DI __device__ __forceinline__
#define LAS __attribute__((address_space(3)))
typedef unsigned short bf16_t;
typedef short bf16x8 __attribute__((ext_vector_type(8)));
typedef float f32x4 __attribute__((ext_vector_type(4)));
typedef float f32x2 __attribute__((ext_vector_type(2)));
typedef unsigned u32x4 __attribute__((ext_vector_type(4)));
typedef unsigned u32x2 __attribute__((ext_vector_type(2)));

constexpr int NB = 2, T = 8192, M = NB * T, D = 2048;
constexpr int NH = 8, HD = 128, GW = 1024, RW = 1024, RGB = 8, RBD = 128;
constexpr int NE = 32, NG = 4, EPG = 8, FF = 512;
constexpr int INCOLS = 6160, NPROJ = 6144;
constexpr float EPS = 1e-6f;
constexpr int NWAVES = 8, NTHREADS = 512;

constexpr size_t MiB = 1u << 20;
constexpr size_t WS_CTL = 0, CTL_BYTES = 1 * MiB;
constexpr size_t WS_BETA = 1 * MiB;
constexpr size_t WS_G = WS_BETA + 512 * 1024;
constexpr size_t WS_RSTD1 = 2 * MiB, WS_RSTD2 = 2 * MiB + 65536;
constexpr size_t WS_WG = 3 * MiB;
constexpr size_t WS_RGSUM = WS_WG + 512 * 1024;
constexpr size_t WS_LIST = 4 * MiB;
constexpr size_t WS_WOUT = 12 * MiB;
constexpr size_t WS_W13 = 20 * MiB;
constexpr size_t WS_W2 = 148 * MiB;
constexpr size_t WS_WIN = 212 * MiB;
constexpr size_t WS_XN = 236 * MiB;
constexpr size_t WS_PROJ = 300 * MiB;
constexpr size_t PROJ_STRIDE = 32 * MiB;
constexpr size_t WS_ORAW = 300 * MiB  ;
constexpr size_t WS_MIX = 492 * MiB;
constexpr size_t WS_X1 = WS_PROJ + 2 * PROJ_STRIDE;
constexpr size_t WS_H2 = WS_WIN;
constexpr size_t WS_HB = 276 * MiB;
constexpr size_t WS_Y2 = WS_W13;
constexpr size_t WS_END = 556 * MiB;
constexpr size_t WS_QG = 20 * MiB, WS_KDT = 52 * MiB, WS_U = 84 * MiB, WS_WN = 116 * MiB, WS_AT = 148 * MiB, WS_GAM = 164 * MiB;
constexpr size_t WS_RGA = WS_WIN;
constexpr size_t WS_RGB = 276 * MiB;

constexpr int CW_CNT = 64;
constexpr int CW_BAR = 4096;

typedef __bf16 bf16x2_t __attribute__((ext_vector_type(2)));
DI unsigned pk2(float lo, float hi) { const f32x2 v = {lo, hi}; return __builtin_bit_cast(unsigned, __builtin_convertvector(v, bf16x2_t)); }
DI unsigned f2bf(float f) { return pk2(f, 0.f) & 0xffffu; }
DI float bf2f(unsigned b) { return __uint_as_float(b << 16); }
DI float bflo(unsigned w) { return __uint_as_float(w << 16); }
DI float bfhi(unsigned w) { return __uint_as_float(w & 0xffff0000u); }
DI float wave_sum(float v) {
#pragma unroll
    for (int o = 1; o < 64; o <<= 1) v += __shfl_xor(v, o);
    return v;
}
DI float sigmoidf_(float x) { return __builtin_amdgcn_rcpf(1.f + __expf(-x)); }
DI float siluf_(float x) { return x * __builtin_amdgcn_rcpf(1.f + __expf(-x)); }
DI float softplusf_(float x) { return x > 20.f ? x : log1pf(expf(x)); }
DI float gelu_tanh(float x) { const float u = 0.7978845608028654f * (x + 0.044715f * x * x * x); return x * __builtin_amdgcn_rcpf(1.f + __expf(-2.f * u)); }

namespace pg8 {
constexpr int BM = 256, BK = 64, HALF = 128, HTB = HALF * BK * 2, STAGE_BYTES = 8 * HTB;
DI int lds_byte(int r, int c) { const int st = (r >> 4) * 2 + (c >> 5), rr = r & 15, cc = c & 31, ob = rr * 64 + cc * 2; return st * 1024 + (ob ^ (((ob >> 9) & 1) << 5)); }
DI void stage_rc(int b, int& R, int& C) { const int st = b / 1024, sb = b % 1024, swz = sb ^ (((sb >> 9) & 1) << 5); R = (st >> 1) * 16 + swz / 64; C = (st & 1) * 32 + (swz % 64) / 2; }
DI int perm32(int rho) { const int n = rho >> 4, i = rho & 15; return 8 * (i >> 2) + 4 * n + (i & 3); }

struct Unit { const char* A; const char* B; int pm, pn; int e, nvalid; const void* rows; };

DI unsigned cvt_pk_bf16(float lo, float hi) { return pk2(lo, hi); }

template <class Epi, class Sched, bool GATHER>
DI void gemm_phase(LAS unsigned char* lds, const int K, const Sched& S, const Epi& E) {
    const int tid = threadIdx.x, wid = __builtin_amdgcn_readfirstlane(tid >> 6), lane = tid & 63, wr = wid >> 2, wc = wid & 3, fr = lane & 15, fq = lane >> 4;
    const int nt = K / BK;
    unsigned voffA[2], voffB[2]; int RA[2], CA[2];
#pragma unroll
    for (int i = 0; i < 2; ++i) { int R, C; stage_rc(tid * 16 + i * 8192, R, C); const int Rb = Epi::PERM ? ((R & ~31) + perm32(R & 31)) : R;
        RA[i] = R; CA[i] = C; voffA[i] = (unsigned)(R * K + C) * 2u; voffB[i] = (unsigned)(Rb * K + C) * 2u; }
    const size_t kstep = (size_t)(BK * 2);
    const size_t hstep = (size_t)HALF * K * 2;
    const unsigned ldsw = (unsigned)wid * 1024u;
    const int aoff = lds_byte(wr * 64 + fr, fq * 8), boff = lds_byte(wc * 32 + fr, fq * 8);
#define PG8_SA(b, h) (((b) * 2 + (h)) * HTB)
#define PG8_SB(b, h) ((4 + (b) * 2 + (h)) * HTB)
#define PG8_STAGE(bufoff, gbase, voff) do { _Pragma("unroll") for (int _i = 0; _i < 2; ++_i) \
        __builtin_amdgcn_global_load_lds((const unsigned*)((const char*)(gbase) + (voff)[_i]), (LAS unsigned*)(lds + (bufoff) + ldsw + _i * 8192), 16, 0, 0); } while (0)
#define PG8_LDA(dst, b, h) do { _Pragma("unroll") for (int m = 0; m < 4; ++m) _Pragma("unroll") for (int k = 0; k < 2; ++k) dst[m][k] = *(const LAS bf16x8*)(lds + PG8_SA(b, h) + aoff + m * 2048 + k * 1024); } while (0)
#define PG8_LDB(dst, b, h) do { _Pragma("unroll") for (int n = 0; n < 2; ++n) _Pragma("unroll") for (int k = 0; k < 2; ++k) dst[n][k] = *(const LAS bf16x8*)(lds + PG8_SB(b, h) + boff + n * 2048 + k * 1024); } while (0)
#define PG8_MMA(ai, bj, At, Bt) do { __builtin_amdgcn_s_setprio(1); _Pragma("unroll") for (int m = 0; m < 4; ++m) _Pragma("unroll") for (int n = 0; n < 2; ++n) _Pragma("unroll") for (int k = 0; k < 2; ++k) \
        acc[ai][bj][m][n] = __builtin_amdgcn_mfma_f32_16x16x32_bf16(Bt[n][k], At[m][k], acc[ai][bj][m][n], 0, 0, 0); __builtin_amdgcn_s_setprio(0); } while (0)
#define PG8_WAIT_V(n) asm volatile("s_waitcnt vmcnt(" #n ")" ::: "memory")
#define PG8_WAIT_L(n) asm volatile("s_waitcnt lgkmcnt(" #n ")" ::: "memory")
#define PG8_BAR __builtin_amdgcn_s_barrier()
#define PG8_SCHED __builtin_amdgcn_sched_barrier(0)
    Unit cur, nxt; int ui = 0;
    if (!S.next(0, cur)) return;
    f32x4 acc[2][2][4][2];
#pragma unroll
    for (int a = 0; a < 2; ++a)
#pragma unroll
        for (int b = 0; b < 2; ++b)
#pragma unroll
            for (int m = 0; m < 4; ++m)
#pragma unroll
                for (int n = 0; n < 2; ++n) acc[a][b][m][n] = (f32x4){0.f, 0.f, 0.f, 0.f};
    bf16x8 At[4][2], B0[2][2], B1[2][2];
    unsigned gc0[2], gc1[2], gn0[2], gn1[2];
    if (GATHER) { S.row_offs(cur, RA, CA, K, gc0, gc1); asm volatile("" : "+v"(gc0[0]), "+v"(gc0[1]), "+v"(gc1[0]), "+v"(gc1[1])); }
    const char* cA = cur.A; const char* cB = cur.B;
    const size_t hA = GATHER ? 0 : hstep;
    PG8_STAGE(PG8_SB(0, 0), cB, voffB);
    if (GATHER) PG8_STAGE(PG8_SA(0, 0), cA, gc0); else PG8_STAGE(PG8_SA(0, 0), cA, voffA);
    PG8_STAGE(PG8_SB(0, 1), cB + hstep, voffB);
    if (GATHER) PG8_STAGE(PG8_SA(0, 1), cA, gc1); else PG8_STAGE(PG8_SA(0, 1), cA + hstep, voffA);
    if (wr == 1) PG8_BAR;
    PG8_WAIT_V(4); PG8_BAR;
    PG8_STAGE(PG8_SB(1, 0), cB + kstep, voffB);
    if (GATHER) PG8_STAGE(PG8_SA(1, 0), cA + kstep, gc0); else PG8_STAGE(PG8_SA(1, 0), cA + kstep, voffA);
    PG8_STAGE(PG8_SB(1, 1), cB + hstep + kstep, voffB);
    PG8_WAIT_V(6); PG8_BAR;
    for (;;) {
        const bool has_next = S.next(ui + 1, nxt);
        const char* nA = has_next ? nxt.A : cA; const char* nB = has_next ? nxt.B : cB;
        if (GATHER) {
            if (has_next) S.row_offs(nxt, RA, CA, K, gn0, gn1); else { gn0[0] = gc0[0]; gn0[1] = gc0[1]; gn1[0] = gc1[0]; gn1[1] = gc1[1]; }
            asm volatile("" : "+v"(gn0[0]), "+v"(gn0[1]), "+v"(gn1[0]), "+v"(gn1[1]));
        }
        for (int t = 0; t < nt; t += 2) {
            const bool last = (t == nt - 2);
            const char* a1 = cA + (size_t)(t + 1) * kstep;
            const char* a2 = last ? nA : cA + (size_t)(t + 2) * kstep; const char* b2 = last ? nB : cB + (size_t)(t + 2) * kstep;
            const char* a3 = a2 + kstep; const char* b3 = b2 + kstep;
            unsigned g20[2], g21[2];
            if (GATHER) { g20[0] = last ? gn0[0] : gc0[0]; g20[1] = last ? gn0[1] : gc0[1]; g21[0] = last ? gn1[0] : gc1[0]; g21[1] = last ? gn1[1] : gc1[1]; }
            PG8_LDB(B0, 0, 0); PG8_SCHED; PG8_LDA(At, 0, 0);
            if (GATHER) PG8_STAGE(PG8_SA(1, 1), a1, gc1); else PG8_STAGE(PG8_SA(1, 1), a1 + hstep, voffA);
            PG8_WAIT_L(8); PG8_BAR; PG8_WAIT_L(0); PG8_MMA(0, 0, At, B0); PG8_BAR; PG8_SCHED;
            PG8_LDB(B1, 0, 1); PG8_STAGE(PG8_SB(0, 0), b2, voffB);
            PG8_BAR; PG8_WAIT_L(0); PG8_MMA(0, 1, At, B1); PG8_BAR;
            PG8_LDA(At, 0, 1);
            if (GATHER) PG8_STAGE(PG8_SA(0, 0), a2, g20); else PG8_STAGE(PG8_SA(0, 0), a2, voffA);
            PG8_BAR; PG8_WAIT_L(0); PG8_MMA(1, 0, At, B0); PG8_BAR; PG8_SCHED;
            PG8_STAGE(PG8_SB(0, 1), b2 + hstep, voffB);
            PG8_WAIT_V(6); PG8_BAR; PG8_MMA(1, 1, At, B1); PG8_BAR;
            PG8_LDB(B0, 1, 0); PG8_SCHED; PG8_LDA(At, 1, 0);
            if (GATHER) PG8_STAGE(PG8_SA(0, 1), a2, g21); else PG8_STAGE(PG8_SA(0, 1), a2 + hstep, voffA);
            PG8_WAIT_L(8); PG8_BAR; PG8_WAIT_L(0); PG8_MMA(0, 0, At, B0); PG8_BAR; PG8_SCHED;
            PG8_LDB(B1, 1, 1); PG8_STAGE(PG8_SB(1, 0), b3, voffB);
            PG8_BAR; PG8_WAIT_L(0); PG8_MMA(0, 1, At, B1); PG8_BAR;
            PG8_LDA(At, 1, 1);
            if (GATHER) PG8_STAGE(PG8_SA(1, 0), a3, g20); else PG8_STAGE(PG8_SA(1, 0), a3, voffA);
            PG8_BAR; PG8_WAIT_L(0); PG8_MMA(1, 0, At, B0); PG8_BAR; PG8_SCHED;
            PG8_STAGE(PG8_SB(1, 1), b3 + hstep, voffB);
            PG8_WAIT_V(6); PG8_BAR; PG8_MMA(1, 1, At, B1); PG8_BAR;
        }
        { int tz = threadIdx.x; asm volatile("" : "+v"(tz));
          const int ewid = tz >> 6, elane = tz & 63; E(acc, cur, ewid >> 2, ewid & 3, elane & 15, elane >> 4); }
        if (!has_next) break;
#pragma unroll
        for (int a = 0; a < 2; ++a)
#pragma unroll
            for (int b = 0; b < 2; ++b)
#pragma unroll
                for (int m = 0; m < 4; ++m)
#pragma unroll
                    for (int n = 0; n < 2; ++n) acc[a][b][m][n] = (f32x4){0.f, 0.f, 0.f, 0.f};
        cur = nxt; cA = nA; cB = nB; ++ui;
        if (GATHER) { gc0[0] = gn0[0]; gc0[1] = gn0[1]; gc1[0] = gn1[0]; gc1[1] = gn1[1]; }
    }
    PG8_WAIT_V(0);
    if (wr == 0) PG8_BAR;
    PG8_BAR;
    (void)hA;
#undef PG8_SA
#undef PG8_SB
#undef PG8_STAGE
#undef PG8_LDA
#undef PG8_LDB
#undef PG8_MMA
#undef PG8_WAIT_V
#undef PG8_WAIT_L
#undef PG8_BAR
#undef PG8_SCHED
}
}

struct DenseSched {
    const char* A; const char* B; int K, nM, nN, nwg, G, c;
    DI void init(const void* A_, const void* B_, int Mrows, int N, int K_, int G_, int c_) { A = (const char*)A_; B = (const char*)B_; K = K_; nM = Mrows / 256; nN = N / 256; nwg = nM * nN; G = G_; c = c_; }
    DI bool next(int i, pg8::Unit& u) const {
        const int L = i * G + c; if (L >= nwg) return false;
        int wgid = L; { const int q = nwg / 8, r = nwg % 8, xcd = wgid % 8, off = wgid / 8; wgid = (xcd < r ? xcd * (q + 1) : r * (q + 1) + (xcd - r) * q) + off; }
        const int nig = 8 * nN, gid = wgid / nig, fm = gid * 8, gsz = (nM - fm) < 8 ? (nM - fm) : 8;
        u.pm = fm + ((wgid % nig) % gsz); u.pn = (wgid % nig) / gsz;
        u.A = A + (size_t)u.pm * 256 * K * 2; u.B = B + (size_t)u.pn * 256 * K * 2; u.e = 0; u.nvalid = 256; u.rows = nullptr; return true;
    }
    DI void row_offs(const pg8::Unit&, const int*, const int*, int, unsigned*, unsigned*) const {}
};
struct MoeSched {
    const char* A; const char* B; int K, NJ, BR, G, c, gather;
    const LAS int* tstart;
    const int* cnt; const char* list;
    DI bool next(int i, pg8::Unit& u) const {
        const int L = i * G + c; const int ttot = __builtin_amdgcn_readfirstlane(tstart[32]); if (L >= ttot * NJ) return false;
        const int tau = L / NJ, j = L % NJ;
        int e = 0;
        for (int q = 1; q < 32; ++q) e += (__builtin_amdgcn_readfirstlane(tstart[q]) <= tau) ? 1 : 0;
        e = __builtin_amdgcn_readfirstlane(e);
        const int lt = tau - __builtin_amdgcn_readfirstlane(tstart[e]);
        int nv = __builtin_amdgcn_readfirstlane(cnt[e]) - lt * 256; nv = nv > 256 ? 256 : nv;
        u.pm = tau; u.pn = j; u.e = e; u.nvalid = nv;
        const size_t roff = ((size_t)e * 16384 + (size_t)lt * 256) * 16, aoffb = gather ? 0 : (size_t)tau * 256 * K * 2, boffb = ((size_t)e * BR + (size_t)j * 256) * K * 2;
        u.rows = list + (((size_t)__builtin_amdgcn_readfirstlane((int)(roff >> 32)) << 32) | (unsigned)__builtin_amdgcn_readfirstlane((int)roff));
        u.A = A + (((size_t)__builtin_amdgcn_readfirstlane((int)(aoffb >> 32)) << 32) | (unsigned)__builtin_amdgcn_readfirstlane((int)aoffb));
        u.B = B + (((size_t)__builtin_amdgcn_readfirstlane((int)(boffb >> 32)) << 32) | (unsigned)__builtin_amdgcn_readfirstlane((int)boffb));
        return true;
    }
    DI void row_offs(const pg8::Unit& u, const int* RA, const int* CA, int K_, unsigned* g0, unsigned* g1) const {
#pragma unroll
        for (int i = 0; i < 2; ++i) {
            const int r0 = RA[i], r1 = RA[i] + 128;
            int t0 = *(const int*)((const char*)u.rows + (size_t)r0 * 16), t1 = *(const int*)((const char*)u.rows + (size_t)r1 * 16);
            t0 = (r0 < u.nvalid) ? (t0 >> 1) : 0; t1 = (r1 < u.nvalid) ? (t1 >> 1) : 0;
            g0[i] = (unsigned)(t0 * K_ + CA[i]) * 2u; g1[i] = (unsigned)(t1 * K_ + CA[i]) * 2u;
        }
    }
};

struct EpiProj {
    static constexpr bool PERM = true;
    bf16_t* base; const float* rstd;
    DI void operator()(const f32x4 (&acc)[2][2][4][2], const pg8::Unit& u, int wr, int wc, int fr, int fq) const {
        const int colt = u.pn * 256; bf16_t* o = base + (size_t)(colt >> 10) * (PROJ_STRIDE / 2);
        const int col0 = (colt & 1023) + wc * 32 + 8 * fq, row0 = u.pm * 256 + wr * 64 + fr;
#pragma unroll
        for (int ai = 0; ai < 2; ++ai)
#pragma unroll
            for (int m = 0; m < 4; ++m) { bf16_t* rowp = o + (size_t)(row0 + ai * 128 + m * 16) * 1024 + col0; const float s = rstd[row0 + ai * 128 + m * 16];
#pragma unroll
                for (int bj = 0; bj < 2; ++bj) { const f32x4 v0 = acc[ai][bj][m][0] * s, v1 = acc[ai][bj][m][1] * s; u32x4 w;
                    w.x = pg8::cvt_pk_bf16(v0[0], v0[1]); w.y = pg8::cvt_pk_bf16(v0[2], v0[3]); w.z = pg8::cvt_pk_bf16(v1[0], v1[1]); w.w = pg8::cvt_pk_bf16(v1[2], v1[3]);
                    *(u32x4*)(rowp + bj * 128) = w; } }
    }
};
struct EpiX1 {
    static constexpr bool PERM = false;
    const float* x; float* x1;
    DI void operator()(const f32x4 (&acc)[2][2][4][2], const pg8::Unit& u, int wr, int wc, int fr, int fq) const {
        const int row0 = u.pm * 256 + wr * 64 + fr, col0 = u.pn * 256 + wc * 32 + 4 * fq;
#pragma unroll
        for (int ai = 0; ai < 2; ++ai)
#pragma unroll
            for (int m = 0; m < 4; ++m) { const size_t off = (size_t)(row0 + ai * 128 + m * 16) * D + col0;
#pragma unroll
                for (int bj = 0; bj < 2; ++bj)
#pragma unroll
                    for (int n = 0; n < 2; ++n) { const f32x4 xv = *(const f32x4*)(x + off + bj * 128 + n * 16); *(f32x4*)(x1 + off + bj * 128 + n * 16) = xv + acc[ai][bj][m][n]; } }
    }
};
struct EpiUp {
    static constexpr bool PERM = true;
    bf16_t* hb;
    DI void operator()(const f32x4 (&acc)[2][2][4][2], const pg8::Unit& u, int wr, int wc, int fr, int fq) const {
        const int col0 = u.pn * 128 + wc * 32 + 8 * fq;
#pragma unroll
        for (int ai = 0; ai < 2; ++ai)
#pragma unroll
            for (int m = 0; m < 4; ++m) { const int r = ai * 128 + wr * 64 + m * 16 + fr;
                const float s = *(const float*)((const char*)u.rows + (size_t)r * 16 + 4);
                float h[8];
#pragma unroll
                for (int n = 0; n < 2; ++n)
#pragma unroll
                    for (int e = 0; e < 4; ++e) { const float a1 = s * acc[ai][0][m][n][e], a3 = s * acc[ai][1][m][n][e]; h[n * 4 + e] = siluf_(a1) * a3; }
                u32x4 w; w.x = pg8::cvt_pk_bf16(h[0], h[1]); w.y = pg8::cvt_pk_bf16(h[2], h[3]); w.z = pg8::cvt_pk_bf16(h[4], h[5]); w.w = pg8::cvt_pk_bf16(h[6], h[7]);
                *(u32x4*)(hb + (size_t)(u.pm * 256 + r) * FF + col0) = w; }
    }
};
struct EpiDown {
    static constexpr bool PERM = true;
    bf16_t* y2;
    DI void operator()(const f32x4 (&acc)[2][2][4][2], const pg8::Unit& u, int wr, int wc, int fr, int fq) const {
        const int col0 = u.pn * 256 + wc * 32 + 8 * fq;
#pragma unroll
        for (int ai = 0; ai < 2; ++ai)
#pragma unroll
            for (int m = 0; m < 4; ++m) { const int r = ai * 128 + wr * 64 + m * 16 + fr;
                if (r < u.nvalid) {
                    const int t2 = *(const int*)((const char*)u.rows + (size_t)r * 16);
                    const float gt = *(const float*)((const char*)u.rows + (size_t)r * 16 + 8);
                    bf16_t* rowp = y2 + (size_t)t2 * D + col0;
#pragma unroll
                    for (int bj = 0; bj < 2; ++bj) { const f32x4 v0 = acc[ai][bj][m][0] * gt, v1 = acc[ai][bj][m][1] * gt; u32x4 w;
                        w.x = pg8::cvt_pk_bf16(v0[0], v0[1]); w.y = pg8::cvt_pk_bf16(v0[2], v0[3]); w.z = pg8::cvt_pk_bf16(v1[0], v1[1]); w.w = pg8::cvt_pk_bf16(v1[2], v1[3]);
                        *(u32x4*)(rowp + bj * 128) = w; } } }
    }
};

#define XB_TMO      128
#define XB_XCNT(j)  (256  + 64 * (j))
#define XB_XSUB(j)  (1280 + 64 * (j))
#define XB_XGEN(j)  (2304 + 64 * (j))
#define XB_TOP      3328
#define XB_TOPGEN   3392
#define XCD_BAR_WORDS 3456
#define XB_SPIN_CAP (1u << 22)
__device__ __forceinline__ unsigned xb_ld(unsigned* p)              { return __hip_atomic_load(p, __ATOMIC_RELAXED, __HIP_MEMORY_SCOPE_AGENT); }
__device__ __forceinline__ unsigned xb_add(unsigned* p, unsigned v) { return __hip_atomic_fetch_add(p, v, __ATOMIC_RELAXED, __HIP_MEMORY_SCOPE_AGENT); }
__device__ __forceinline__ unsigned xb_xcc_id() { return (unsigned)__builtin_amdgcn_s_getreg((3 << 11) | 20) & 0xFu; }
#define XB_SPIN(cond, bar) do { unsigned _sp = 0; while (cond) { __builtin_amdgcn_s_sleep(1); \
    if ((++_sp & 255u) == 0u) { if (xb_ld(&(bar)[XB_TMO])) break; if (_sp > XB_SPIN_CAP) { atomicAdd(&(bar)[XB_TMO], 1u); break; } } } } while (0)
struct XcdBarrier { unsigned* bar; unsigned x; volatile LAS unsigned* st; };
__device__ __forceinline__ XcdBarrier xcd_barrier_post(unsigned* bar, volatile LAS unsigned* st) {
    XcdBarrier b; b.bar = bar; b.x = xb_xcc_id(); b.st = st;
    if (threadIdx.x == 0) (void)xb_add(&bar[XB_XCNT(b.x)], 1u);
    return b;
}
__device__ __forceinline__ void xcd_barrier_complete(unsigned* bar, unsigned x, unsigned& nloc, unsigned& nx) {
    const unsigned G = gridDim.x * gridDim.y * gridDim.z;
    unsigned sum, cnt, mine, sp = 0u;
    for (;;) {
        sum = 0u; cnt = 0u; mine = 0u;
#pragma unroll
        for (unsigned j = 0; j < 16; ++j) { const unsigned c = xb_ld(&bar[XB_XCNT(j)]); sum += c; cnt += (c > 0u) ? 1u : 0u; mine = (j == x) ? c : mine; }
        if (sum == G) break;
        __builtin_amdgcn_s_sleep(1);
        if ((++sp & 255u) == 0u) { if (xb_ld(&bar[XB_TMO])) break; if (sp > XB_SPIN_CAP) { atomicAdd(&bar[XB_TMO], 1u); break; } }
    }
    nloc = mine > 0u ? mine : 1u; nx = cnt > 0u ? cnt : 1u;
}
__device__ __forceinline__ void xcd_barrier(const XcdBarrier& b) {
    asm volatile("s_waitcnt vmcnt(0)" ::: "memory");
    __syncthreads();
    if (threadIdx.x == 0) {
        unsigned* bar = b.bar;
        __builtin_amdgcn_s_waitcnt(0);
        unsigned nloc = b.st[0], nx = b.st[1];
        if (nloc == 0u) { xcd_barrier_complete(bar, b.x, nloc, nx); b.st[0] = nloc; b.st[1] = nx; }
        const unsigned old = xb_add(&bar[XB_XSUB(b.x)], 1u);
        const unsigned gen = old / nloc;
        if (old + 1u == (gen + 1u) * nloc) {
            __builtin_amdgcn_fence(__ATOMIC_RELEASE, "agent");
            asm volatile("s_waitcnt vmcnt(0)" ::: "memory");
            const unsigned og = xb_add(&bar[XB_TOP], 1u);
            const unsigned tg = og / nx;
            if (og + 1u == (tg + 1u) * nx) xb_add(&bar[XB_TOPGEN], 1u);
            else XB_SPIN(xb_ld(&bar[XB_TOPGEN]) == tg, bar);
            __builtin_amdgcn_fence(__ATOMIC_ACQUIRE, "agent");
            xb_add(&bar[XB_XGEN(b.x)], 1u);
            asm volatile("s_waitcnt vmcnt(0)" ::: "memory");
        } else {
            XB_SPIN(xb_ld(&bar[XB_XGEN(b.x)]) == gen, bar);
            __builtin_amdgcn_fence(__ATOMIC_ACQUIRE, "agent");
            asm volatile("s_waitcnt vmcnt(0)" ::: "memory");
        }
    }
    __syncthreads();
}

struct Args { const float* in[25]; float* out; unsigned char* ws; int ph_lo, ph_hi; };
enum { I_X = 0, I_NMW, I_WIN, I_GCW, I_ALOG, I_DTB, I_GNW, I_RCW, I_RCB, I_WRG, I_BRG, I_WIG, I_BIG, I_LAM, I_RNW, I_WOUT, I_NFW, I_RWG, I_RBG, I_RWE, I_RBE, I_W1, I_W3, I_W2, I_NFIN };

constexpr int LDS_STAGE = 131072, LDS_BYTES = 147456, LDS_MISC = LDS_BYTES - 1024, LDS_TSTART = LDS_MISC + 256;

DI void transpose_item(const float* W, int ldw, bf16_t* WT, int ldt, LAS float* scr, int k0, int n0, int drow0, int lane) {
    (void)scr;
    const int kg = lane >> 3, n4 = lane & 7;
    const float* src = W + (size_t)(k0 + 8 * kg) * ldw + n0 + 4 * n4;
    f32x4 v[8];
#pragma unroll
    for (int e = 0; e < 8; ++e) v[e] = *(const f32x4*)(src + (size_t)e * ldw);
#pragma unroll
    for (int i = 0; i < 4; ++i) { u32x4 o; o.x = pk2(v[0][i], v[1][i]); o.y = pk2(v[2][i], v[3][i]); o.z = pk2(v[4][i], v[5][i]); o.w = pk2(v[6][i], v[7][i]);
        *(u32x4*)(WT + (size_t)(drow0 + 4 * n4 + i) * ldt + k0 + 8 * kg) = o; }
}

template <int PART>
DI void p0_weights(const Args& a, LAS unsigned char* lds, int gw, int NGW, int wave, int lane) {
    LAS float* scr = (LAS float*)(lds + wave * 16384);
    unsigned char* ws = a.ws;
    constexpr int S0 = 32 * 128, S1 = 32 * 64, S2 = 32 * 64, S3 = 32 * 512, S4 = S3, S5 = 32 * 512, S6 = 64, S7 = 64;
    constexpr int NITEMS = S0 + S1 + S2 + S3 + S4 + S5 + S6 + S7;
    constexpr int LO = PART == 0 ? 0 : S0 + S1 + S2, HI = PART == 0 ? S0 + S1 + S2 : S0 + S1 + S2 + S3 + S4 + S5, EX0 = NITEMS - S6 - S7;
    for (int it0 = gw; it0 < (HI - LO) + (PART == 0 ? S6 + S7 : 0); it0 += NGW) {
        int r = it0 < (HI - LO) ? LO + it0 : EX0 + (it0 - (HI - LO));
        if (r < S0) { const int kb = r / 128, nb = r % 128; transpose_item(a.in[I_WIN], INCOLS, (bf16_t*)(ws + WS_WIN), D, scr, kb * 64, nb * 32, nb * 32, lane); continue; } r -= S0;
        if (r < S1) { const int kb = r / 64, nb = r % 64; transpose_item(a.in[I_WIN] + 4112, INCOLS, (bf16_t*)(ws + WS_WIN), D, scr, kb * 64, nb * 32, 4096 + nb * 32, lane); continue; } r -= S1;
        if (r < S2) { const int kb = r / 64, nb = r % 64; transpose_item(a.in[I_WOUT], D, (bf16_t*)(ws + WS_WOUT), D, scr, kb * 64, nb * 32, nb * 32, lane); continue; } r -= S2;
        if (r < S3 + S4) { const int w3 = r >= S3; if (w3) r -= S3; const int e = r / 512, q = r % 512, kb = q / 16, nb = q % 16, n0 = nb * 32;
            const int drow = (n0 >> 7) * 256 + (n0 & 127) + (w3 ? 128 : 0);
            transpose_item(a.in[w3 ? I_W3 : I_W1] + (size_t)e * D * FF, FF, (bf16_t*)(ws + WS_W13) + (size_t)e * 1024 * D, D, scr, kb * 64, n0, drow, lane); continue; } r -= S3 + S4;
        if (r < S5) { const int e = r / 512, q = r % 512, kb = q / 64, nb = q % 64;
            transpose_item(a.in[I_W2] + (size_t)e * FF * D, D, (bf16_t*)(ws + WS_W2) + (size_t)e * D * FF, FF, scr, kb * 64, nb * 32, nb * 32, lane); continue; } r -= S5;
        { const int ig = r >= S6; if (ig) r -= S6; const int n = r / 8, q = r % 8, kb = q / 4, nb = q % 4;
            transpose_item(a.in[ig ? I_WIG : I_WRG] + (size_t)n * 128 * 128, 128, (bf16_t*)(ws + WS_WG) + (size_t)n * 256 * 128, 128, scr, kb * 64, nb * 32, nb * 32 + (ig ? 128 : 0), lane); }
    }
}

template <int MODE>
DI void row_pass16(const Args& a, const float* __restrict__ X, const float* __restrict__ wn, bf16_t* __restrict__ XNb, float* RSTD, int row0, int lane, int w, LAS float* part, LAS float* lg) {
    constexpr int NT = MODE == 0 ? 1 : 3;
    const int c = lane & 15, g = lane >> 4;
    f32x4 acc[NT];
#pragma unroll
    for (int t = 0; t < NT; ++t) acc[t] = (f32x4){0.f, 0.f, 0.f, 0.f};
    float ss = 0.f;
    const int kw = 256 * w;
    const int lo_x = c * D + 8 * g, lo_w = 8 * g;
    const int lo_b = MODE == 0 ? 8 * g * INCOLS + c : 8 * g * 32 + c, lo_g = 8 * g * 4 + (c < 4 ? c : 0);
    constexpr int BST = MODE == 0 ? INCOLS : 32;
    const float* xb = X + (size_t)row0 * D + kw; bf16_t* xob = XNb + (size_t)row0 * D + kw;
    const float* wb_ = wn + kw;
    const __amdgpu_buffer_rsrc_t rb = __builtin_amdgcn_make_buffer_rsrc((void*)(MODE == 0 ? a.in[I_WIN] : a.in[I_RWE]), (short)0, MODE == 0 ? D * INCOLS * 4 : D * 32 * 4, 0x00020000);
    const __amdgpu_buffer_rsrc_t rg_ = __builtin_amdgcn_make_buffer_rsrc((void*)a.in[I_RWG], (short)0, D * 4 * 4, 0x00020000);
    const int sb0 = (kw * BST + (MODE == 0 ? 4096 : 0)) * 4, sg0 = kw * 16;
    constexpr int GS = MODE == 0 ? 4 : 2;
#pragma unroll
    for (int S2 = 0; S2 < 8; S2 += GS) {
        f32x4 xa[GS][2], wa[GS][2]; float bb[GS][8][NT];
#pragma unroll
        for (int u = 0; u < GS; ++u) { const int S = S2 + u;
            xa[u][0] = *(const f32x4*)((xb + 32 * S) + lo_x); xa[u][1] = *(const f32x4*)((xb + 32 * S + 4) + lo_x);
            wa[u][0] = *(const f32x4*)((wb_ + 32 * S) + lo_w); wa[u][1] = *(const f32x4*)((wb_ + 32 * S + 4) + lo_w);
#pragma unroll
            for (int e = 0; e < 8; ++e) { const int so = sb0 + (32 * S + e) * BST * 4;
                bb[u][e][0] = __builtin_bit_cast(float, __builtin_amdgcn_raw_buffer_load_b32(rb, lo_b * 4, so, 0));
                if (MODE == 1) { bb[u][e][1] = __builtin_bit_cast(float, __builtin_amdgcn_raw_buffer_load_b32(rb, lo_b * 4, so + 64, 0));
                    const float b2 = __builtin_bit_cast(float, __builtin_amdgcn_raw_buffer_load_b32(rg_, lo_g * 4, sg0 + (32 * S + e) * 16, 0)); bb[u][e][NT - 1] = c < 4 ? b2 : 0.f; } } }
#pragma unroll
        for (int u = 0; u < GS; ++u) { const int S = S2 + u;
            f32x4 x0 = xa[u][0], x1 = xa[u][1];
            ss += (x0[0] * x0[0] + x0[1] * x0[1]) + (x0[2] * x0[2] + x0[3] * x0[3]) + (x1[0] * x1[0] + x1[1] * x1[1]) + (x1[2] * x1[2] + x1[3] * x1[3]);
            x0 = x0 * wa[u][0]; x1 = x1 * wa[u][1];
            u32x4 o; o.x = pk2(x0[0], x0[1]); o.y = pk2(x0[2], x0[3]); o.z = pk2(x1[0], x1[1]); o.w = pk2(x1[2], x1[3]);
            *(u32x4*)((xob + 32 * S) + lo_x) = o;
#pragma unroll
            for (int e = 0; e < 8; ++e) { const float av = e < 4 ? x0[e & 3] : x1[e & 3];
#pragma unroll
                for (int t = 0; t < NT; ++t) acc[t] = __builtin_amdgcn_mfma_f32_16x16x4f32(av, bb[u][e][t], acc[t], 0, 0, 0); } }
    }
    ss += __shfl_xor(ss, 16); ss += __shfl_xor(ss, 32);
    { LAS float* pp = part + (w * 64 + lane) * 16;
#pragma unroll
      for (int t = 0; t < NT; ++t) *(LAS f32x4*)(pp + 4 * t) = acc[t];
      pp[12] = ss; }
    __syncthreads();
    if (w != 0) return;
    float rssum = 0.f;
#pragma unroll
    for (int t = 0; t < NT; ++t) acc[t] = (f32x4){0.f, 0.f, 0.f, 0.f};
#pragma unroll
    for (int ww = 0; ww < 8; ++ww) { const LAS float* pp = part + (ww * 64 + lane) * 16;
#pragma unroll
        for (int t = 0; t < NT; ++t) acc[t] = acc[t] + *(const LAS f32x4*)(pp + 4 * t);
        rssum += pp[12]; }
    const float rstd = rsqrtf(rssum * (1.f / D) + EPS);
    if (g == 0) RSTD[row0 + c] = rstd;
    float rs[4];
#pragma unroll
    for (int r = 0; r < 4; ++r) rs[r] = __shfl(rstd, 4 * g + r);
    if (MODE == 0) {
        const int hh = c & 7; const float al = __expf(a.in[I_ALOG][hh]), dtb = a.in[I_DTB][hh];
        float* BETA = (float*)(a.ws + WS_BETA); float* GG = (float*)(a.ws + WS_G);
#pragma unroll
        for (int r = 0; r < 4; ++r) { const float v = rs[r] * acc[0][r]; const int row = row0 + 4 * g + r;
            if (c < 8) BETA[(size_t)row * 8 + hh] = sigmoidf_(v); else GG[(size_t)row * 8 + hh] = -al * softplusf_(v + dtb); }
    } else {
        const float be0 = a.in[I_RBE][c], be1 = a.in[I_RBE][16 + c], bg = a.in[I_RBG][c < 4 ? c : 0];
#pragma unroll
        for (int r = 0; r < 4; ++r) { const int rr = 4 * g + r; lg[rr * 40 + c] = rs[r] * acc[0][r] + be0; lg[rr * 40 + 16 + c] = rs[r] * acc[1][r] + be1; if (c < 4) lg[rr * 40 + 32 + c] = rs[r] * acc[NT - 1][r] + bg; }
        asm volatile("s_waitcnt lgkmcnt(0)" ::: "memory");
        if (lane < 16) {
            const LAS float* L = lg + lane * 40; const int token = row0 + lane;
            float gm = L[32]; int gi = 0;
#pragma unroll
            for (int q = 1; q < 4; ++q) if (L[32 + q] > gm) { gm = L[32 + q]; gi = q; }
            float gs = 0.f;
#pragma unroll
            for (int q = 0; q < 4; ++q) gs += __expf(L[32 + q] - gm);
            const float gp = 1.f / gs;
            float ev[8];
#pragma unroll
            for (int q = 0; q < 8; ++q) ev[q] = L[gi * 8 + q];
            float m1 = ev[0]; int i1 = 0;
#pragma unroll
            for (int q = 1; q < 8; ++q) if (ev[q] > m1) { m1 = ev[q]; i1 = q; }
            float m2 = -3.0e38f; int i2 = 0;
#pragma unroll
            for (int q = 0; q < 8; ++q) if (q != i1 && ev[q] > m2) { m2 = ev[q]; i2 = q; }
            const float p2 = __expf(m2 - m1), den = 1.f / (1.f + p2);
            const float g1 = gp * den, g2 = gp * p2 * den;
            int* cnt = (int*)(a.ws + WS_CTL) + CW_CNT;
            const int e1 = gi * 8 + i1, e2 = gi * 8 + i2;
            const int s1 = atomicAdd(cnt + e1, 1), s2 = atomicAdd(cnt + e2, 1);
            f32x4* l1 = (f32x4*)(a.ws + WS_LIST + ((size_t)e1 * 16384 + s1) * 16); f32x4* l2 = (f32x4*)(a.ws + WS_LIST + ((size_t)e2 * 16384 + s2) * 16);
            *l1 = (f32x4){__int_as_float(token * 2), rstd, g1, 0.f}; *l2 = (f32x4){__int_as_float(token * 2 + 1), rstd, g2, 0.f};
        }
        asm volatile("s_waitcnt lgkmcnt(0)" ::: "memory");
    }
}

DI void final_row(const float* x1, const bf16_t* y2, const float* w, float* out, int row, int lane) {
    const f32x4* xr = (const f32x4*)(x1 + (size_t)row * D) + lane;
    const u32x2* ya = (const u32x2*)(y2 + (size_t)(2 * row) * D) + lane; const u32x2* yb = (const u32x2*)(y2 + (size_t)(2 * row + 1) * D) + lane;
    f32x4 v[8]; float ss = 0.f;
#pragma unroll
    for (int j = 0; j < 8; ++j) { const f32x4 x = xr[64 * j]; const u32x2 p = ya[64 * j], q = yb[64 * j];
        v[j] = (f32x4){x[0] + bflo(p.x) + bflo(q.x), x[1] + bfhi(p.x) + bfhi(q.x), x[2] + bflo(p.y) + bflo(q.y), x[3] + bfhi(p.y) + bfhi(q.y)};
        ss += (v[j][0] * v[j][0] + v[j][1] * v[j][1]) + (v[j][2] * v[j][2] + v[j][3] * v[j][3]); }
    const float rstd = rsqrtf(wave_sum(ss) * (1.f / D) + EPS);
    f32x4* o = (f32x4*)(out + (size_t)row * D) + lane; const f32x4* wr = (const f32x4*)w + lane;
#pragma unroll
    for (int j = 0; j < 8; ++j) o[64 * j] = v[j] * rstd * wr[64 * j];
}

DI void naive_gdn(const Args& a, LAS unsigned char* lds, int bh, int tid) {
    LAS float (*sq)[128] = (LAS float (*)[128])(lds), (*sk)[128] = (LAS float (*)[128])(lds + 8192), (*sv)[128] = (LAS float (*)[128])(lds + 16384);
    LAS float (*red)[128] = (LAS float (*)[128])(lds + 24576), (*red2)[128] = (LAS float (*)[128])(lds + 26624);
    const int b = bh >> 3, h = bh & 7, lane = tid & 63, wave = tid >> 6;
    const bf16_t* P = (const bf16_t*)(a.ws + WS_PROJ);
    const float* gcw = a.in[I_GCW]; const float* BETA = (const float*)(a.ws + WS_BETA); const float* GG = (const float*)(a.ws + WS_G);
    float* ORAW = (float*)(a.ws + WS_ORAW);
    const int dvi = tid & 127, dkg = tid >> 7;
    float S[32];
#pragma unroll
    for (int j = 0; j < 32; ++j) S[j] = 0.f;
    for (int t0 = 0; t0 < T; t0 += 16) {
        for (int idx = tid; idx < 16 * 384; idx += 512) {
            const int tok = idx / 384, ch = idx % 384, which = ch >> 7, d = ch & 127, col = h * 128 + d, tt = t0 + tok;
            const bf16_t* src = P + (size_t)which * (PROJ_STRIDE / 2);
            float acc = 0.f;
#pragma unroll
            for (int j = 0; j < 4; ++j) { const int ts = tt - 3 + j; if (ts >= 0) acc += gcw[j * 3072 + which * 1024 + col] * bf2f(src[(size_t)(b * T + ts) * 1024 + col]); }
            const float v = siluf_(acc);
            if (which == 0) sq[tok][d] = v; else if (which == 1) sk[tok][d] = v; else sv[tok][d] = v;
        }
        __syncthreads();
        for (int q = wave; q < 32; q += 8) { const int tok = q >> 1; LAS float* p = (q & 1) ? sk[tok] : sq[tok];
            const float v0 = p[lane], v1 = p[lane + 64]; const float ss = wave_sum(v0 * v0 + v1 * v1);
            const float sc = rsqrtf(ss + EPS) * ((q & 1) ? 1.f : 0.08838834764831845f); p[lane] = v0 * sc; p[lane + 64] = v1 * sc; }
        __syncthreads();
        for (int tok = 0; tok < 16; ++tok) {
            const size_t row = (size_t)b * T + t0 + tok;
            const float eg = __expf(GG[row * 8 + h]), bt = BETA[row * 8 + h];
            float p = 0.f;
#pragma unroll
            for (int j = 0; j < 32; ++j) { S[j] *= eg; p += S[j] * sk[tok][dkg * 32 + j]; }
            red[dkg][dvi] = p;
            __syncthreads();
            const float kv = (red[0][dvi] + red[1][dvi]) + (red[2][dvi] + red[3][dvi]);
            const float delta = bt * (sv[tok][dvi] - kv);
            float po = 0.f;
#pragma unroll
            for (int j = 0; j < 32; ++j) { S[j] += sk[tok][dkg * 32 + j] * delta; po += S[j] * sq[tok][dkg * 32 + j]; }
            red2[dkg][dvi] = po;
            __syncthreads();
            if (dkg == 0) ORAW[row * 1024 + h * 128 + dvi] = (red2[0][dvi] + red2[1][dvi]) + (red2[2][dvi] + red2[3][dvi]);
        }
        __syncthreads();
    }
}
DI void naive_gdn_final(const Args& a, int gwv, int lane) {
    const int row = gwv >> 3, h = gwv & 7;
    const float* o = (const float*)(a.ws + WS_ORAW) + (size_t)row * 1024 + h * 128;
    const bf16_t* z = (const bf16_t*)(a.ws + WS_PROJ + 3 * PROJ_STRIDE) + (size_t)row * 1024 + h * 128;
    bf16_t* mix = (bf16_t*)(a.ws + WS_MIX) + (size_t)row * D + h * 128;
    const float v0 = o[lane], v1 = o[lane + 64]; const float rstd = rsqrtf(wave_sum(v0 * v0 + v1 * v1) * (1.f / 128.f) + EPS);
    mix[lane] = (bf16_t)f2bf(v0 * rstd * a.in[I_GNW][lane] * siluf_(bf2f(z[lane])));
    mix[lane + 64] = (bf16_t)f2bf(v1 * rstd * a.in[I_GNW][lane + 64] * siluf_(bf2f(z[lane + 64])));
}
DI void naive_rg_gates(const Args& a, LAS unsigned char* lds, int blk, int tid) {
    LAS float (*xc)[128] = (LAS float (*)[128])(lds);
    const int n = blk & 7, r0 = (blk >> 3) * 32;
    const bf16_t* RX = (const bf16_t*)(a.ws + WS_PROJ + 4 * PROJ_STRIDE);
    float* RA = (float*)(a.ws + WS_RGA); float* RB = (float*)(a.ws + WS_RGB);
    __syncthreads();
    for (int idx = tid; idx < 4096; idx += 512) { const int tok = idx >> 7, i = idx & 127, ch = n * 128 + i, row = r0 + tok, t = row % T;
        float acc = a.in[I_RCB][ch];
#pragma unroll
        for (int j = 0; j < 4; ++j) { const int ts = t - 3 + j; if (ts >= 0) acc += a.in[I_RCW][j * 1024 + ch] * bf2f(RX[(size_t)(row - 3 + j) * 1024 + ch]); }
        xc[tok][i] = acc; }
    __syncthreads();
    const int j = tid & 127, q4 = tid >> 7, ch = n * 128 + j;
    const float* Wr = a.in[I_WRG] + (size_t)n * 16384; const float* Wi = a.in[I_WIG] + (size_t)n * 16384;
    const float sp = softplusf_(-a.in[I_LAM][ch]);
    for (int tok = q4 * 8; tok < q4 * 8 + 8; ++tok) {
        float ar = a.in[I_BRG][ch], ai = a.in[I_BIG][ch];
        for (int i = 0; i < 128; ++i) { const float x = xc[tok][i]; ar += x * Wr[i * 128 + j]; ai += x * Wi[i * 128 + j]; }
        const float r = sigmoidf_(ar), ig = sigmoidf_(ai), la = -8.f * r * sp, av = __expf(la), mult = sqrtf(-expm1f(2.f * la));
        RA[(size_t)(r0 + tok) * 1024 + ch] = av; RB[(size_t)(r0 + tok) * 1024 + ch] = mult * ig * xc[tok][j]; }
}
DI void naive_rg_scan(const Args& a, int id) {
    const int b = id >> 10, ch = id & 1023;
    float* RA = (float*)(a.ws + WS_RGA); const float* RB = (const float*)(a.ws + WS_RGB);
    const bf16_t* RG = (const bf16_t*)(a.ws + WS_PROJ + 5 * PROJ_STRIDE);
    float h = 0.f;
    for (int t = 0; t < T; ++t) { const size_t o = (size_t)(b * T + t) * 1024 + ch; h = RA[o] * h + RB[o]; RA[o] = h * gelu_tanh(bf2f(RG[o])); }
}
DI void naive_rg_norm(const Args& a, int gwv, int lane) {
    const int row = gwv >> 3, n = gwv & 7;
    const float* y = (const float*)(a.ws + WS_RGA) + (size_t)row * 1024 + n * 128;
    bf16_t* mix = (bf16_t*)(a.ws + WS_MIX) + (size_t)row * D + 1024 + n * 128;
    const float v0 = y[lane], v1 = y[lane + 64]; const float rstd = rsqrtf(wave_sum(v0 * v0 + v1 * v1) * (1.f / 128.f) + EPS);
    mix[lane] = (bf16_t)f2bf(v0 * rstd * a.in[I_RNW][n * 128 + lane]); mix[lane + 64] = (bf16_t)f2bf(v1 * rstd * a.in[I_RNW][n * 128 + lane + 64]);
}

constexpr int GP_GC = 0, GP_BT = 256, GP_KB = 1024, GP_QB = GP_KB + 17408, GP_VBT = GP_QB + 17408, GP_KBT = GP_VBT + 18432, GP_KDT = GP_KBT + 18432, GP_AM = GP_KDT + 16384, GP_TM = GP_AM + 16384;
DI void gdn_prep(const Args& a, LAS unsigned char* lds, int uid, int tid) {
    const int lane = tid & 63, w = __builtin_amdgcn_readfirstlane(tid >> 6), fr = lane & 15, fq = lane >> 4;
    const int n = uid & 127, bh = uid >> 7, h = bh & 7, b = bh >> 3;
    const size_t row0 = (size_t)b * T + (size_t)n * 64;
    LAS float* gc = (LAS float*)(lds + GP_GC); LAS float* bt = (LAS float*)(lds + GP_BT);
    LAS unsigned char* Kb = lds + GP_KB; LAS unsigned char* Qb = lds + GP_QB; LAS unsigned char* VbT = lds + GP_VBT; LAS unsigned char* KbT = lds + GP_KBT; LAS unsigned char* KdT = lds + GP_KDT;
    LAS float* Am = (LAS float*)(lds + GP_AM); LAS unsigned char* Tm = lds + GP_TM;
    const float* BETA = (const float*)(a.ws + WS_BETA); const float* GG = (const float*)(a.ws + WS_G);
    const bf16_t* P = (const bf16_t*)(a.ws + WS_PROJ);
    bf16_t* QG = (bf16_t*)(a.ws + WS_QG) + (size_t)uid * 8192; bf16_t* KDT = (bf16_t*)(a.ws + WS_KDT) + (size_t)uid * 8192;
    bf16_t* UU = (bf16_t*)(a.ws + WS_U) + (size_t)uid * 8192; bf16_t* WN = (bf16_t*)(a.ws + WS_WN) + (size_t)uid * 8192; bf16_t* AT = (bf16_t*)(a.ws + WS_AT) + (size_t)uid * 4096;
    __syncthreads();
    if (w == 0) { float c = GG[(row0 + lane) * 8 + h];
#pragma unroll
        for (int o = 1; o < 64; o <<= 1) { const float v = __shfl_up(c, o); if (lane >= o) c += v; }
        gc[lane] = c; bt[lane] = BETA[(row0 + lane) * 8 + h]; if (lane == 63) ((float*)(a.ws + WS_GAM))[uid] = __expf(c); }
    __syncthreads();
    { const int c8 = tid & 15, r = tid >> 4; const float glast = gc[63];
#pragma unroll
      for (int q2 = 0; q2 < 2; ++q2) {
        const int i = r + 32 * q2, t = n * 64 + i; const size_t row = row0 + i;
        float val[3][8];
#pragma unroll
        for (int wh = 0; wh < 3; ++wh) {
            float acc[8];
#pragma unroll
            for (int e = 0; e < 8; ++e) acc[e] = 0.f;
#pragma unroll
            for (int j = 0; j < 4; ++j) { if (t - 3 + j >= 0) { const u32x4 raw = *(const u32x4*)(P + (size_t)wh * (PROJ_STRIDE / 2) + (row - 3 + j) * 1024 + h * 128 + 8 * c8);
                const float* cw = a.in[I_GCW] + j * 3072 + wh * 1024 + h * 128 + 8 * c8;
#pragma unroll
                for (int i2 = 0; i2 < 4; ++i2) { acc[2 * i2] += cw[2 * i2] * bflo(raw[i2]); acc[2 * i2 + 1] += cw[2 * i2 + 1] * bfhi(raw[i2]); } } }
#pragma unroll
            for (int e = 0; e < 8; ++e) val[wh][e] = siluf_(acc[e]);
        }
        float ssq = 0.f, ssk = 0.f;
#pragma unroll
        for (int e = 0; e < 8; ++e) { ssq += val[0][e] * val[0][e]; ssk += val[1][e] * val[1][e]; }
#pragma unroll
        for (int o = 1; o < 16; o <<= 1) { ssq += __shfl_xor(ssq, o); ssk += __shfl_xor(ssk, o); }
        const float qs = rsqrtf(ssq + EPS) * 0.08838834764831845f, ks = rsqrtf(ssk + EPS);
        const float gci = gc[i], ei = __expf(gci), bi = bt[i], ed = __expf(glast - gci);
        float qh[8], kh[8];
#pragma unroll
        for (int e = 0; e < 8; ++e) { qh[e] = val[0][e] * qs; kh[e] = val[1][e] * ks; }
        u32x4 o;
        o.x = pk2(qh[0], qh[1]); o.y = pk2(qh[2], qh[3]); o.z = pk2(qh[4], qh[5]); o.w = pk2(qh[6], qh[7]); *(LAS u32x4*)(Qb + i * 272 + 16 * c8) = o;
        o.x = pk2(kh[0], kh[1]); o.y = pk2(kh[2], kh[3]); o.z = pk2(kh[4], kh[5]); o.w = pk2(kh[6], kh[7]); *(LAS u32x4*)(Kb + i * 272 + 16 * c8) = o;
        o.x = pk2(qh[0] * ei, qh[1] * ei); o.y = pk2(qh[2] * ei, qh[3] * ei); o.z = pk2(qh[4] * ei, qh[5] * ei); o.w = pk2(qh[6] * ei, qh[7] * ei); *(u32x4*)(QG + i * 128 + 8 * c8) = o;
#pragma unroll
        for (int e = 0; e < 8; ++e) { const int d = 8 * c8 + e;
            *(LAS bf16_t*)(KbT + d * 144 + 2 * i) = (bf16_t)f2bf(kh[e] * bi * ei);
            *(LAS bf16_t*)(VbT + d * 144 + 2 * i) = (bf16_t)f2bf(val[2][e] * bi);
            *(LAS bf16_t*)(KdT + d * 128 + 2 * i) = (bf16_t)f2bf(kh[e] * ed); }
      } }
    __syncthreads();
    { const int mat = w >> 2, it = w & 3; LAS unsigned char* Ab = mat ? Qb : Kb;
      bf16x8 Afr[4];
#pragma unroll
      for (int ks = 0; ks < 4; ++ks) Afr[ks] = *(const LAS bf16x8*)(Ab + (16 * it + fr) * 272 + (32 * ks + 8 * fq) * 2);
#pragma unroll
      for (int jt = 0; jt < 4; ++jt) {
        f32x4 acc = (f32x4){0.f, 0.f, 0.f, 0.f};
        if (jt <= it) {
#pragma unroll
            for (int ks = 0; ks < 4; ++ks) acc = __builtin_amdgcn_mfma_f32_16x16x32_bf16(Afr[ks], *(const LAS bf16x8*)(Kb + (16 * jt + fr) * 272 + (32 * ks + 8 * fq) * 2), acc, 0, 0, 0);
        }
        const int j = 16 * jt + fr; const float gcj = gc[j];
#pragma unroll
        for (int r = 0; r < 4; ++r) { const int i = 16 * it + 4 * fq + r; const float dec = __expf(fminf(gc[i] - gcj, 0.f));
            if (mat == 0) Am[i * 64 + j] = (i > j) ? bt[i] * acc[r] * dec : 0.f;
            else AT[i * 64 + j] = (bf16_t)f2bf((i >= j) ? acc[r] * dec : 0.f); }
      } }
#pragma unroll
    for (int q2 = 0; q2 < 2; ++q2) { const int pc = tid + 512 * q2; *(u32x4*)(KDT + pc * 8) = *(const LAS u32x4*)(KdT + pc * 16); }
    __syncthreads();
    { LAS float* Dinv = (LAS float*)(lds + GP_QB);
      if (w < 4) {
        const int c = lane & 15; int cz = c; asm volatile("" : "+v"(cz));
        float Al[120];
#pragma unroll
        for (int i = 1; i < 16; ++i)
#pragma unroll
            for (int j = 0; j < i; ++j) Al[i * (i - 1) / 2 + j] = Am[(16 * w + i) * 64 + 16 * w + j];
        __builtin_amdgcn_sched_barrier(0);
        float X[16];
#pragma unroll
        for (int i = 0; i < 16; ++i) { float acc = (i == cz) ? 1.f : 0.f;
#pragma unroll
            for (int j = 0; j < i; ++j) acc -= Al[i * (i - 1) / 2 + j] * X[j];
            X[i] = acc; }
        if (lane < 16) {
#pragma unroll
            for (int i = 0; i < 16; ++i) Dinv[w * 256 + i * 16 + c] = X[i];
        }
      }
      __syncthreads();
      if (w < 4) {
        const int c = w;
        f32x4 Tc[4];
#pragma unroll
        for (int bb = 0; bb < 4; ++bb) Tc[bb] = (f32x4){0.f, 0.f, 0.f, 0.f};
#pragma unroll
        for (int bb = 0; bb < 4; ++bb) {
            if (bb == c) {
#pragma unroll
                for (int r = 0; r < 4; ++r) Tc[bb][r] = Dinv[c * 256 + (4 * fq + r) * 16 + fr];
            } else if (bb > c) {
                f32x4 Pm = (f32x4){0.f, 0.f, 0.f, 0.f};
#pragma unroll
                for (int k = 0; k < 3; ++k) { if (k >= c && k < bb) {
                    const f32x4 av = *(const LAS f32x4*)(Am + (16 * bb + fr) * 64 + 16 * k + 4 * fq);
#pragma unroll
                    for (int e = 0; e < 4; ++e) Pm = __builtin_amdgcn_mfma_f32_16x16x4f32(av[e], Tc[k][e], Pm, 0, 0, 0); } }
                const f32x4 dv = *(const LAS f32x4*)(Dinv + bb * 256 + fr * 16 + 4 * fq);
                f32x4 R = (f32x4){0.f, 0.f, 0.f, 0.f};
#pragma unroll
                for (int e = 0; e < 4; ++e) R = __builtin_amdgcn_mfma_f32_16x16x4f32(dv[e], Pm[e], R, 0, 0, 0);
                Tc[bb] = -R;
            }
        }
#pragma unroll
        for (int bb = 0; bb < 4; ++bb)
#pragma unroll
            for (int r = 0; r < 4; ++r) *(LAS bf16_t*)(Tm + (16 * bb + 4 * fq + r) * 144 + (16 * c + fr) * 2) = (bf16_t)f2bf(Tc[bb][r]);
      }
    }
    __syncthreads();
    { const int mat = w >> 2, it = w & 3; LAS unsigned char* Xb = mat ? KbT : VbT; bf16_t* Og = mat ? WN : UU; const float sg = mat ? -1.f : 1.f;
      bf16x8 Tfr[2];
#pragma unroll
      for (int ks = 0; ks < 2; ++ks) Tfr[ks] = *(const LAS bf16x8*)(Tm + (16 * it + fr) * 144 + (32 * ks + 8 * fq) * 2);
#pragma unroll
      for (int dt = 0; dt < 8; ++dt) {
        f32x4 acc = (f32x4){0.f, 0.f, 0.f, 0.f};
#pragma unroll
        for (int ks = 0; ks < 2; ++ks) acc = __builtin_amdgcn_mfma_f32_16x16x32_bf16(Tfr[ks], *(const LAS bf16x8*)(Xb + (16 * dt + fr) * 144 + (32 * ks + 8 * fq) * 2), acc, 0, 0, 0);
#pragma unroll
        for (int r = 0; r < 4; ++r) Og[(16 * it + 4 * fq + r) * 128 + 16 * dt + fr] = (bf16_t)f2bf(sg * acc[r]);
      } }
}

constexpr int GS_WN = 0, GS_QG = 17408, GS_AT = 34816, GS_KDT = 44032, GS_U = 62464, GS_BUF = 67584, GS_GAM = 2 * GS_BUF;
DI void gs_piece(int pc, int uid, int q4, const unsigned char* ws, const bf16_t*& src, int& dst) {
    if (pc < 1024) { const int row = pc >> 4, c = pc & 15; src = (const bf16_t*)(ws + WS_WN) + (size_t)uid * 8192 + row * 128 + c * 8; dst = GS_WN + row * 272 + c * 16; }
    else if (pc < 2048) { const int p2 = pc - 1024, row = p2 >> 4, c = p2 & 15; src = (const bf16_t*)(ws + WS_QG) + (size_t)uid * 8192 + row * 128 + c * 8; dst = GS_QG + row * 272 + c * 16; }
    else if (pc < 2560) { const int p2 = pc - 2048, row = p2 >> 3, c = p2 & 7; src = (const bf16_t*)(ws + WS_AT) + (size_t)uid * 4096 + row * 64 + c * 8; dst = GS_AT + row * 144 + c * 16; }
    else if (pc < 3584) { const int p2 = pc - 2560, row = p2 >> 3, c = p2 & 7; src = (const bf16_t*)(ws + WS_KDT) + (size_t)uid * 8192 + row * 64 + c * 8; dst = GS_KDT + row * 144 + c * 16; }
    else { const int p2 = pc - 3584, row = p2 >> 2, c = p2 & 3; src = (const bf16_t*)(ws + WS_U) + (size_t)uid * 8192 + row * 128 + q4 * 32 + c * 8; dst = GS_U + row * 80 + c * 16; }
}
DI bf16x8 gs_lda(const LAS unsigned char* base, int row, int stride, int k0, int fq) {
    const u32x2 lo = *(const LAS u32x2*)(base + row * stride + (k0 + 4 * fq) * 2), hi = *(const LAS u32x2*)(base + row * stride + (k0 + 16 + 4 * fq) * 2);
    u32x4 v; v.x = lo.x; v.y = lo.y; v.z = hi.x; v.w = hi.y; return __builtin_bit_cast(bf16x8, v);
}
DI bf16x8 gs_pack(const f32x4& lo, const f32x4& hi) {
    u32x4 v; v.x = pg8::cvt_pk_bf16(lo[0], lo[1]); v.y = pg8::cvt_pk_bf16(lo[2], lo[3]); v.z = pg8::cvt_pk_bf16(hi[0], hi[1]); v.w = pg8::cvt_pk_bf16(hi[2], hi[3]); return __builtin_bit_cast(bf16x8, v);
}
DI void gdn_scan(const Args& a, LAS unsigned char* lds, int su, int tid) {
    const int lane = tid & 63, w = __builtin_amdgcn_readfirstlane(tid >> 6), fr = lane & 15, fq = lane >> 4;
    const int q4 = su & 3, bh = su >> 2, h = bh & 7, b = bh >> 3, uid0 = bh * 128;
    const int lt = tid - 128;
    bf16_t* ORAW = (bf16_t*)(a.ws + WS_ORAW);
    const float* GAM = (const float*)(a.ws + WS_GAM);
    LAS float* gaml = (LAS float*)(lds + GS_GAM);
    __syncthreads();
    u32x4 pv[10]; int pdst[10];
    if (w >= 2) {
#pragma unroll
        for (int k = 0; k < 10; ++k) { const bf16_t* src; int dst; gs_piece(lt + 384 * k, uid0, q4, a.ws, src, dst); *(LAS u32x4*)(lds + dst) = *(const u32x4*)src; }
        if (lt == 0) gaml[0] = GAM[uid0];
#pragma unroll
        for (int k = 0; k < 10; ++k) { const bf16_t* src; gs_piece(lt + 384 * k, uid0 + 1, q4, a.ws, src, pdst[k]); pv[k] = *(const u32x4*)src; }
    }
    f32x4 S[8];
#pragma unroll
    for (int kt = 0; kt < 8; ++kt) S[kt] = (f32x4){0.f, 0.f, 0.f, 0.f};
    __syncthreads();
#ifdef PROBE_SCAN2
    constexpr int NCH = 384;
#else
    constexpr int NCH = 128;
#endif
    for (int c2 = 0; c2 < NCH; ++c2) {
        const int c = c2 & 127;
        if (NCH > 128 && c == 0) {
#pragma unroll
            for (int kt = 0; kt < 8; ++kt) S[kt] = (f32x4){0.f, 0.f, 0.f, 0.f};
        }
        LAS unsigned char* Bf = lds + (c & 1) * GS_BUF;
        if (w >= 2) {
            if (c2 + 1 < NCH) {
                const int cn = (c + 1) & 127; LAS unsigned char* Nb = lds + (cn & 1) * GS_BUF;
#pragma unroll
                for (int k = 0; k < 10; ++k) *(LAS u32x4*)(Nb + pdst[k]) = pv[k];
                if (lt == 0) gaml[cn & 1] = GAM[uid0 + cn];
                if (c2 + 2 < NCH) { const int c3 = (c + 2) & 127;
#pragma unroll
                    for (int k = 0; k < 10; ++k) { const bf16_t* src; gs_piece(lt + 384 * k, uid0 + c3, q4, a.ws, src, pdst[k]); pv[k] = *(const u32x4*)src; } }
            }
        } else {
            const size_t rowc = (size_t)b * T + (size_t)c * 64;
            bf16x8 Sb[4];
#pragma unroll
            for (int ks = 0; ks < 4; ++ks) Sb[ks] = gs_pack(S[2 * ks], S[2 * ks + 1]);
            f32x4 vn[4], o[4];
#pragma unroll
            for (int mt = 0; mt < 4; ++mt) {
#pragma unroll
                for (int r = 0; r < 4; ++r) vn[mt][r] = bf2f(*(const LAS bf16_t*)(Bf + GS_U + (16 * mt + 4 * fq + r) * 80 + (16 * w + fr) * 2));
                o[mt] = (f32x4){0.f, 0.f, 0.f, 0.f};
#pragma unroll
                for (int ks = 0; ks < 4; ++ks) {
                    vn[mt] = __builtin_amdgcn_mfma_f32_16x16x32_bf16(gs_lda(Bf + GS_WN, 16 * mt + fr, 272, 32 * ks, fq), Sb[ks], vn[mt], 0, 0, 0);
                    o[mt] = __builtin_amdgcn_mfma_f32_16x16x32_bf16(gs_lda(Bf + GS_QG, 16 * mt + fr, 272, 32 * ks, fq), Sb[ks], o[mt], 0, 0, 0);
                }
            }
            bf16x8 Vb[2];
#pragma unroll
            for (int js = 0; js < 2; ++js) Vb[js] = gs_pack(vn[2 * js], vn[2 * js + 1]);
#pragma unroll
            for (int mt = 0; mt < 4; ++mt) {
#pragma unroll
                for (int js = 0; js < 2; ++js) o[mt] = __builtin_amdgcn_mfma_f32_16x16x32_bf16(gs_lda(Bf + GS_AT, 16 * mt + fr, 144, 32 * js, fq), Vb[js], o[mt], 0, 0, 0);
#pragma unroll
                for (int r = 0; r < 4; ++r) ORAW[(rowc + 16 * mt + 4 * fq + r) * 1024 + h * 128 + q4 * 32 + 16 * w + fr] = (bf16_t)f2bf(o[mt][r]);
            }
            const float gam = gaml[c & 1];
#pragma unroll
            for (int kt = 0; kt < 8; ++kt) { S[kt] = S[kt] * gam;
#pragma unroll
                for (int js = 0; js < 2; ++js) S[kt] = __builtin_amdgcn_mfma_f32_16x16x32_bf16(gs_lda(Bf + GS_KDT, 16 * kt + fr, 144, 32 * js, fq), Vb[js], S[kt], 0, 0, 0); }
        }
        asm volatile("s_waitcnt lgkmcnt(0)" ::: "memory"); __builtin_amdgcn_s_barrier(); asm volatile("" ::: "memory");
    }
    __syncthreads();
}
DI void gdn_final(const Args& a, int q4i, int lane) {
    const int pair = q4i * 4 + (lane >> 4), row = pair >> 3, h = pair & 7, l16 = lane & 15;
    const u32x4 ov = *((const u32x4*)((const bf16_t*)(a.ws + WS_ORAW) + (size_t)row * 1024 + h * 128) + l16);
    const u32x4 zv = *((const u32x4*)((const bf16_t*)(a.ws + WS_PROJ + 3 * PROJ_STRIDE) + (size_t)row * 1024 + h * 128) + l16);
    const f32x4 w0 = *((const f32x4*)a.in[I_GNW] + 2 * l16), w1 = *((const f32x4*)a.in[I_GNW] + 2 * l16 + 1);
    float v[8] = {bflo(ov.x), bfhi(ov.x), bflo(ov.y), bfhi(ov.y), bflo(ov.z), bfhi(ov.z), bflo(ov.w), bfhi(ov.w)};
    const float zf[8] = {bflo(zv.x), bfhi(zv.x), bflo(zv.y), bfhi(zv.y), bflo(zv.z), bfhi(zv.z), bflo(zv.w), bfhi(zv.w)};
    float ss = 0.f;
#pragma unroll
    for (int e = 0; e < 8; ++e) ss += v[e] * v[e];
#pragma unroll
    for (int o = 1; o < 16; o <<= 1) ss += __shfl_xor(ss, o);
    const float rstd = rsqrtf(ss * (1.f / 128.f) + EPS);
#pragma unroll
    for (int e = 0; e < 8; ++e) v[e] = v[e] * rstd * (e < 4 ? w0[e & 3] : w1[e & 3]) * siluf_(zf[e]);
    u32x4 o; o.x = pk2(v[0], v[1]); o.y = pk2(v[2], v[3]); o.z = pk2(v[4], v[5]); o.w = pk2(v[6], v[7]);
    *((u32x4*)((bf16_t*)(a.ws + WS_MIX) + (size_t)row * D + h * 128) + l16) = o;
}

template <int PASS>
DI void rg_unit(const Args& a, LAS unsigned char* lds, int unit, int tid) {
    const int lane = tid & 63, w = tid >> 6, fr = lane & 15, fq = lane >> 4;
    const int cg = unit & 3, tc = (unit >> 2) & 31, b = unit >> 7;
    const int n = cg * 2 + (w >> 2), jb = 32 * (w & 3), wb = (w >> 2) * 128;
    constexpr int XS = 528;
    LAS unsigned char* Xc = lds; LAS unsigned char* Gt = lds + 33792; LAS float* Ps = (LAS float*)(lds + 67584);
    const bf16_t* RX = (const bf16_t*)(a.ws + WS_PROJ + 4 * PROJ_STRIDE); const bf16_t* RG = (const bf16_t*)(a.ws + WS_PROJ + 5 * PROJ_STRIDE);
    bf16_t* MIX = (bf16_t*)(a.ws + WS_MIX);
    float* SUMA = (float*)(a.ws + WS_RGSUM); float* SUMH = SUMA + 2 * 32 * 1024;
    const int c8 = tid & 31, r16 = tid >> 5, chs = cg * 256 + 8 * c8;
    bf16x8 Bw[2][2][4];
    { const bf16_t* Wg = (const bf16_t*)(a.ws + WS_WG) + (size_t)n * 256 * 128;
#pragma unroll
      for (int gt = 0; gt < 2; ++gt)
#pragma unroll
        for (int jt = 0; jt < 2; ++jt)
#pragma unroll
          for (int ks = 0; ks < 4; ++ks) Bw[gt][jt][ks] = *(const bf16x8*)(Wg + (size_t)(gt * 128 + jb + 16 * jt + fr) * 128 + 32 * ks + 8 * fq); }
    float sp[2], br[2], bi[2]; int chl[2];
#pragma unroll
    for (int jt = 0; jt < 2; ++jt) { chl[jt] = jb + 16 * jt + fr; const int ch = n * 128 + chl[jt]; sp[jt] = softplusf_(-a.in[I_LAM][ch]); br[jt] = a.in[I_BRG][ch]; bi[jt] = a.in[I_BIG][ch]; }
    float hin[2] = {0.f, 0.f}, Arun[2] = {1.f, 1.f}, Brun[2] = {0.f, 0.f};
    if (PASS == 1) {
        for (int tcp = 0; tcp < tc; ++tcp)
#pragma unroll
            for (int jt = 0; jt < 2; ++jt) { const size_t o = (size_t)(b * 32 + tcp) * 1024 + n * 128 + chl[jt]; hin[jt] = SUMA[o] * hin[jt] + SUMH[o]; }
    }
    for (int s = 0; s < 4; ++s) {
        const int t0 = tc * 256 + 64 * s;
        __syncthreads();
#pragma unroll
        for (int q = 0; q < 4; ++q) {
            const int tok = r16 + 16 * q, t = t0 + tok; const size_t row = (size_t)b * T + t;
            float xv[8];
#pragma unroll
            for (int e = 0; e < 8; ++e) xv[e] = a.in[I_RCB][chs + e];
#pragma unroll
            for (int j = 0; j < 4; ++j) { if (t - 3 + j >= 0) { const u32x4 raw = *(const u32x4*)(RX + (row - 3 + j) * 1024 + chs); const float* cwj = a.in[I_RCW] + j * 1024 + chs;
#pragma unroll
                for (int i = 0; i < 4; ++i) { xv[2 * i] += cwj[2 * i] * bflo(raw[i]); xv[2 * i + 1] += cwj[2 * i + 1] * bfhi(raw[i]); } } }
            u32x4 o; o.x = pk2(xv[0], xv[1]); o.y = pk2(xv[2], xv[3]); o.z = pk2(xv[4], xv[5]); o.w = pk2(xv[6], xv[7]);
            *(LAS u32x4*)(Xc + tok * XS + 16 * c8) = o;
            if (PASS == 1) *(LAS u32x4*)(Gt + tok * XS + 16 * c8) = *(const u32x4*)(RG + row * 1024 + chs);
        }
        __syncthreads();
        float pss[4][4];
#pragma unroll
        for (int m = 0; m < 4; ++m)
#pragma unroll
            for (int r = 0; r < 4; ++r) pss[m][r] = 0.f;
#pragma unroll
        for (int m = 0; m < 4; ++m) {
            bf16x8 Af[4];
#pragma unroll
            for (int ks = 0; ks < 4; ++ks) Af[ks] = *(const LAS bf16x8*)(Xc + (16 * m + fr) * XS + (wb + 32 * ks + 8 * fq) * 2);
            f32x4 acc[2][2];
#pragma unroll
            for (int gt = 0; gt < 2; ++gt)
#pragma unroll
                for (int jt = 0; jt < 2; ++jt) { acc[gt][jt] = (f32x4){0.f, 0.f, 0.f, 0.f};
#pragma unroll
                    for (int ks = 0; ks < 4; ++ks) acc[gt][jt] = __builtin_amdgcn_mfma_f32_16x16x32_bf16(Af[ks], Bw[gt][jt][ks], acc[gt][jt], 0, 0, 0); }
#pragma unroll
            for (int jt = 0; jt < 2; ++jt) {
                float av[4], bv[4];
#pragma unroll
                for (int r = 0; r < 4; ++r) { const int tl = 16 * m + 4 * fq + r;
                    const float xcv = bf2f(*(const LAS bf16_t*)(Xc + tl * XS + (wb + chl[jt]) * 2));
                    const float rr = sigmoidf_(acc[0][jt][r] + br[jt]), ii = sigmoidf_(acc[1][jt][r] + bi[jt]), la = -8.f * rr * sp[jt];
                    av[r] = __expf(la); bv[r] = __builtin_amdgcn_sqrtf(fmaxf(1.f - av[r] * av[r], 0.f)) * ii * xcv; }
                float A = av[0], B = bv[0];
#pragma unroll
                for (int r = 1; r < 4; ++r) { B = B * av[r] + bv[r]; A *= av[r]; }
                float pA = __shfl_up(A, 16), pB = __shfl_up(B, 16); if (fq >= 1) { B = pB * A + B; A = pA * A; }
                pA = __shfl_up(A, 32); pB = __shfl_up(B, 32); if (fq >= 2) { B = pB * A + B; A = pA * A; }
                float Ae = __shfl_up(A, 16), Be = __shfl_up(B, 16); if (fq == 0) { Ae = 1.f; Be = 0.f; }
                const float At = __shfl(A, fr + 48), Bt = __shfl(B, fr + 48);
                if (PASS == 0) { Brun[jt] = At * Brun[jt] + Bt; Arun[jt] *= At; }
                else { float h = Ae * hin[jt] + Be;
#pragma unroll
                    for (int r = 0; r < 4; ++r) { const int tl = 16 * m + 4 * fq + r; h = av[r] * h + bv[r];
                        LAS bf16_t* gp = (LAS bf16_t*)(Gt + tl * XS + (wb + chl[jt]) * 2); const float y = h * gelu_tanh(bf2f(*gp)); *gp = (bf16_t)f2bf(y); pss[m][r] += y * y; }
                    hin[jt] = At * hin[jt] + Bt; }
            }
        }
        if (PASS == 1) {
#pragma unroll
            for (int m = 0; m < 4; ++m)
#pragma unroll
                for (int r = 0; r < 4; ++r) { float v = pss[m][r]; v += __shfl_xor(v, 1); v += __shfl_xor(v, 2); v += __shfl_xor(v, 4); v += __shfl_xor(v, 8); if (fr == 0) Ps[w * 64 + 16 * m + 4 * fq + r] = v; }
            __syncthreads();
            { const int w0 = 4 * (c8 >> 4); float nwv[8];
#pragma unroll
              for (int e = 0; e < 8; ++e) nwv[e] = a.in[I_RNW][chs + e];
#pragma unroll
              for (int q = 0; q < 4; ++q) { const int tok = r16 + 16 * q; const size_t row = (size_t)b * T + t0 + tok;
                const float tot = (Ps[w0 * 64 + tok] + Ps[(w0 + 1) * 64 + tok]) + (Ps[(w0 + 2) * 64 + tok] + Ps[(w0 + 3) * 64 + tok]);
                const float rstd = rsqrtf(tot * (1.f / 128.f) + EPS);
                const u32x4 yr = *(const LAS u32x4*)(Gt + tok * XS + 16 * c8); u32x4 o;
                o.x = pk2(bflo(yr.x) * rstd * nwv[0], bfhi(yr.x) * rstd * nwv[1]); o.y = pk2(bflo(yr.y) * rstd * nwv[2], bfhi(yr.y) * rstd * nwv[3]);
                o.z = pk2(bflo(yr.z) * rstd * nwv[4], bfhi(yr.z) * rstd * nwv[5]); o.w = pk2(bflo(yr.w) * rstd * nwv[6], bfhi(yr.w) * rstd * nwv[7]);
                *(u32x4*)(MIX + row * D + 1024 + chs) = o; } }
        }
    }
    if (PASS == 0 && fq == 0) {
#pragma unroll
        for (int jt = 0; jt < 2; ++jt) { const size_t o = (size_t)(b * 32 + tc) * 1024 + n * 128 + chl[jt]; SUMA[o] = Arun[jt]; SUMH[o] = Brun[jt]; }
    }
}

constexpr int NPHASES = 11;
__global__ void __launch_bounds__(NTHREADS, 2) fwd(Args a) {
    extern __shared__ __attribute__((aligned(16))) unsigned char lds_raw[];
    LAS unsigned char* lds = (LAS unsigned char*)lds_raw;
    const int tid = threadIdx.x, lane = tid & 63, wave = __builtin_amdgcn_readfirstlane(tid >> 6);
    const int G = gridDim.x, bx = blockIdx.x;
    const int vcu = (G % 8 == 0) ? (bx % 8) * (G / 8) + bx / 8 : bx;
    const int gw = vcu * NWAVES + wave, NGW = G * NWAVES;
    unsigned char* ws = a.ws;
    const int lo = a.ph_lo, hi = a.ph_hi;
    if (tid < 16) ((LAS unsigned*)(lds + LDS_MISC))[tid] = 0u;
    __syncthreads();
    XcdBarrier bar; bar.bar = (unsigned*)(ws + WS_CTL) + CW_BAR; bar.x = 0; bar.st = nullptr;
    if (hi - lo > 1) bar = xcd_barrier_post((unsigned*)(ws + WS_CTL) + CW_BAR, (volatile LAS unsigned*)(lds + LDS_MISC));
#define IN(k) (lo <= (k) && (k) < hi)
#define SEAM(k) do { if (IN(k) && IN((k) + 1)) xcd_barrier(bar); } while (0)
#ifndef PROBE_REP
#define PROBE_REP -1
#endif
#define REPS(k) _Pragma("unroll") for (int rep_ = 0; rep_ < ((k) == PROBE_REP ? 3 : 1); ++rep_, (((k) == PROBE_REP && rep_ < 3) ? xcd_barrier(bar) : (void)0))
    if (IN(0)) REPS(0) {
        p0_weights<0>(a, lds, gw, NGW, wave, lane);
        __syncthreads();
        for (int task = vcu, it_ = 0; task < M / 16; task += G, ++it_) row_pass16<0>(a, a.in[I_X], a.in[I_NMW], (bf16_t*)(ws + WS_XN), (float*)(ws + WS_RSTD1), task * 16, lane, wave, (LAS float*)(lds + (it_ & 1) * 32768), nullptr);
    }
    SEAM(0);
    if (IN(1)) REPS(1) {
        DenseSched S; S.init(ws + WS_XN, ws + WS_WIN, M, NPROJ, D, G, bx);
        EpiProj E{(bf16_t*)(ws + WS_PROJ), (const float*)(ws + WS_RSTD1)};
        pg8::gemm_phase<EpiProj, DenseSched, false>(lds, D, S, E);
    }
    SEAM(1);
    if (IN(2)) { constexpr int R2 = (PROBE_REP == 2) ? 3 : 1; for (int u = bx; u < 256 * R2; u += G) rg_unit<0>(a, lds, u & 255, tid); for (int u = bx; u < 2048 * R2; u += G) gdn_prep(a, lds, u & 2047, tid); }
    SEAM(2);
    if (IN(3)) REPS(3) {
        if (bx < 64) gdn_scan(a, lds, bx, tid);
        else for (int u = bx - 64; u < 256; u += G - 64) rg_unit<1>(a, lds, u, tid);
    }
    SEAM(3);
    if (IN(4)) REPS(4) {
#pragma unroll 4
        for (int q = gw; q < M * 2; q += NGW) gdn_final(a, q, lane); __syncthreads(); p0_weights<1>(a, lds, gw, NGW, wave, lane); }
    SEAM(4);
    if (IN(5)) { }
    SEAM(5);
    if (IN(6)) REPS(6) {
        DenseSched S; S.init(ws + WS_MIX, ws + WS_WOUT, M, D, D, G, bx);
        EpiX1 E{a.in[I_X], (float*)(ws + WS_X1)};
        pg8::gemm_phase<EpiX1, DenseSched, false>(lds, D, S, E);
    }
    SEAM(6);
    if (IN(7)) {
        LAS float* lg = (LAS float*)(lds + 65536);
        for (int task = vcu, it_ = 0; task < M / 16; task += G, ++it_) row_pass16<1>(a, (const float*)(ws + WS_X1), a.in[I_NFW], (bf16_t*)(ws + WS_H2), (float*)(ws + WS_RSTD2), task * 16, lane, wave, (LAS float*)(lds + (it_ & 1) * 32768), lg + (it_ & 1) * 1024);
    }
    SEAM(7);
    if (IN(8) || IN(9)) {
        LAS int* tstart = (LAS int*)(lds + LDS_TSTART);
        const int* cnt = (const int*)(ws + WS_CTL) + CW_CNT;
        if (wave == 0) { const int cn = lane < 32 ? cnt[lane] : 0; const int ntl = (cn + 255) >> 8; int incl = ntl;
#pragma unroll
            for (int o = 1; o < 32; o <<= 1) { const int v = __shfl_up(incl, o); if (lane >= o) incl += v; }
            if (lane < 32) tstart[lane] = incl - ntl; if (lane == 31) tstart[32] = incl; }
        __syncthreads();
        if (IN(8)) REPS(8) {
            MoeSched S{(const char*)(ws + WS_H2), (const char*)(ws + WS_W13), D, 4, 1024, G, bx, 1, tstart, cnt, (const char*)(ws + WS_LIST)};
            EpiUp E{(bf16_t*)(ws + WS_HB)};
            pg8::gemm_phase<EpiUp, MoeSched, true>(lds, D, S, E);
        }
        SEAM(8);
        if (IN(9)) REPS(9) {
            MoeSched S{(const char*)(ws + WS_HB), (const char*)(ws + WS_W2), FF, 8, 2048, G, bx, 0, tstart, cnt, (const char*)(ws + WS_LIST)};
            EpiDown E{(bf16_t*)(ws + WS_Y2)};
            pg8::gemm_phase<EpiDown, MoeSched, false>(lds, FF, S, E);
        }
    }
    SEAM(9);
    if (IN(10)) REPS(10) {
        for (int row = gw; row < M; row += NGW) final_row((const float*)(ws + WS_X1), (const bf16_t*)(ws + WS_Y2), a.in[I_NFIN], a.out, row, lane);
    }
#undef IN
#undef SEAM
}

#ifndef N_LAUNCHES
#define N_LAUNCHES 1
#endif
extern "C" void kernel_launch(void* const* d_in, const int* in_sizes, int n_in, void* d_out, int out_size, void* d_ws, size_t ws_size, hipStream_t stream) {
    static int grid = 0;
    if (grid == 0) {
        if (n_in != 25 || ws_size < WS_END) { fprintf(stderr, "kernel_launch: unexpected n_in %d or ws_size %zu (< %zu)\n", n_in, ws_size, (size_t)WS_END); grid = -1; return; }
        int dev = 0, cus = 0; (void)hipGetDevice(&dev); (void)hipDeviceGetAttribute(&cus, hipDeviceAttributeMultiprocessorCount, dev);
        if (hipFuncSetAttribute((const void*)fwd, hipFuncAttributeMaxDynamicSharedMemorySize, LDS_BYTES) != hipSuccess) { fprintf(stderr, "kernel_launch: hipFuncSetAttribute failed\n"); grid = -1; return; }
        int per_cu = 0; (void)hipOccupancyMaxActiveBlocksPerMultiprocessor(&per_cu, (const void*)fwd, NTHREADS, LDS_BYTES); (void)hipGetLastError();
        if (per_cu < 1) fprintf(stderr, "kernel_launch: occupancy query reports %d blocks per CU\n", per_cu);
        grid = cus > 0 ? cus : 256;
    }
    if (grid < 0) return;
    (void)hipMemsetAsync((char*)d_ws + WS_CTL, 0, CTL_BYTES, stream);
    Args a{};
    for (int i = 0; i < 25; ++i) a.in[i] = (const float*)d_in[i];
    a.out = (float*)d_out; a.ws = (unsigned char*)d_ws;
    if (N_LAUNCHES == 1) { a.ph_lo = 0; a.ph_hi = NPHASES; hipLaunchKernelGGL(fwd, dim3(grid), dim3(NTHREADS), LDS_BYTES, stream, a); }
    else for (int p = 0; p < NPHASES; ++p) { a.ph_lo = p; a.ph_hi = p + 1; hipLaunchKernelGGL(fwd, dim3(grid), dim3(NTHREADS), LDS_BYTES, stream, a); }
}
```
